# Optimizing an MI355X kernel written in HIP

```python
import jax, jax.numpy as jnp
from jax import lax
import numpy as np

D_MODEL = 2048
BATCH = 2
SEQ = 4096
DEPTH = 1

HEAD_DIM = 64
N_Q_HEADS = 16
N_KV_HEADS = 4
GROUP = N_Q_HEADS // N_KV_HEADS
WINDOW = 128
Q_W = N_Q_HEADS * HEAD_DIM
KV_W = N_KV_HEADS * HEAD_DIM
POOL_WINDOWS = (2, 4, 8, 16)
N_POOL_GROUPS = len(POOL_WINDOWS)
POOL_W = D_MODEL // 2
POOL_GC = POOL_W // N_POOL_GROUPS
N_BRANCHES = 2
IN_W = Q_W + 2 * KV_W + POOL_W + N_BRANCHES * D_MODEL
N_EXPERTS = 32
TOP_K = 4
D_FF = D_MODEL
SWIGLU_LIMIT = 7.0
SWIGLU_ALPHA = 1.702
EXPERT_BLOCK = 256
N_MOD = 6
RMS_EPS = 1e-6
NEG_INF = -1e30

kernel_name = "hybrid_swa_sink_pool_moe_block"


def rms_norm(x, g):
    xf = x.astype(jnp.float32)
    y = xf * lax.rsqrt(jnp.mean(xf * xf, axis=-1, keepdims=True) + RMS_EPS)
    return (y * g.astype(jnp.float32)).astype(x.dtype)


def sliding_window_sink_attention(q, k, v, sinks):
    B, S, _ = q.shape
    nb = S // WINDOW
    qb = q.reshape(B, nb, WINDOW, N_KV_HEADS, GROUP, HEAD_DIM)

    def band_blocks(t):
        t = t.reshape(B, S, N_KV_HEADS, HEAD_DIM)
        tp = jnp.pad(t, ((0, 0), (WINDOW, 0), (0, 0), (0, 0)))
        prev = tp[:, :S].reshape(B, nb, WINDOW, N_KV_HEADS, HEAD_DIM)
        cur = tp[:, WINDOW:].reshape(B, nb, WINDOW, N_KV_HEADS, HEAD_DIM)
        return jnp.concatenate([prev, cur], axis=2)

    kb, vb = band_blocks(k), band_blocks(v)
    s = jnp.einsum('bnqhgd,bnkhd->bnhgqk', qb, kb).astype(jnp.float32) * (HEAD_DIM ** -0.5)
    qpos = jnp.arange(WINDOW)[:, None] + WINDOW
    kpos = jnp.arange(2 * WINDOW)[None, :]
    diff = qpos - kpos
    band = (diff >= 0) & (diff < WINDOW)
    valid = (jnp.arange(nb)[:, None] > 0) | (jnp.arange(2 * WINDOW)[None, :] >= WINDOW)
    mask = band[None, :, :] & valid[:, None, :]
    s = jnp.where(mask[None, :, None, None, :, :], s, NEG_INF)
    sink = jnp.broadcast_to(
        sinks.astype(jnp.float32).reshape(N_KV_HEADS, GROUP)[None, None, :, :, None, None],
        s.shape[:-1] + (1,))
    p = jax.nn.softmax(jnp.concatenate([s, sink], axis=-1), axis=-1)[..., :-1]
    o = jnp.einsum('bnhgqk,bnkhd->bnqhgd', p.astype(vb.dtype), vb)
    return o.reshape(B, S, Q_W)


def multiscale_causal_pool(u):
    B, S, _ = u.shape
    ug = u.reshape(B, S, N_POOL_GROUPS, POOL_GC).astype(jnp.float32)
    cs = jnp.cumsum(ug, axis=1)
    t = jnp.arange(S)
    outs = []
    for g, w in enumerate(POOL_WINDOWS):
        csg = cs[:, :, g]
        prev = jnp.pad(csg, ((0, 0), (w, 0), (0, 0)))[:, :S]
        cnt = jnp.minimum(t + 1, w).astype(jnp.float32)[None, :, None]
        outs.append((csg - prev) / cnt)
    mean = jnp.stack(outs, axis=2)
    return (mean - ug).astype(u.dtype)


def clamped_swiglu(gu):
    x_glu = jnp.minimum(gu[..., ::2], SWIGLU_LIMIT)
    x_lin = jnp.clip(gu[..., 1::2], -SWIGLU_LIMIT, SWIGLU_LIMIT)
    return x_glu * jax.nn.sigmoid(SWIGLU_ALPHA * x_glu) * (x_lin + 1.0)


def moe_ffn(h, w_router, b_router, w_gate_up, b_gate_up, w_down, b_down):
    B, S, D = h.shape
    T = B * S
    hf = h.reshape(T, D)
    logits = (hf @ w_router + b_router).astype(jnp.float32)
    top_val, top_idx = lax.top_k(logits, TOP_K)
    gate_w = jax.nn.softmax(top_val, axis=-1)
    n_assign = T * TOP_K
    flat_e = top_idx.reshape(-1)
    flat_tok = jnp.repeat(jnp.arange(T, dtype=jnp.int32), TOP_K)
    flat_w = gate_w.reshape(-1)
    order = jnp.argsort(flat_e)
    se = flat_e[order]
    counts = jnp.bincount(flat_e, length=N_EXPERTS)
    pcounts = (counts + EXPERT_BLOCK - 1) // EXPERT_BLOCK * EXPERT_BLOCK
    pend = jnp.cumsum(pcounts)
    pstart = pend - pcounts
    ustart = jnp.cumsum(counts) - counts
    dest = pstart[se] + jnp.arange(n_assign) - ustart[se]
    nblk = -(-n_assign // EXPERT_BLOCK) + N_EXPERTS
    npad = nblk * EXPERT_BLOCK
    row_tok = jnp.zeros((npad,), jnp.int32).at[dest].set(flat_tok[order])
    row_w = jnp.zeros((npad,), jnp.float32).at[dest].set(flat_w[order])
    blk_e = jnp.minimum(
        jnp.searchsorted(pend, jnp.arange(nblk) * EXPERT_BLOCK, side='right'), N_EXPERTS - 1)
    xb = hf[row_tok].reshape(nblk, EXPERT_BLOCK, D)

    def expert_block(args):
        xblk, e = args
        gu = xblk @ w_gate_up[e] + b_gate_up[e]
        return clamped_swiglu(gu) @ w_down[e] + b_down[e]

    yb = lax.map(expert_block, (xb, blk_e)).reshape(npad, D)
    y = jnp.zeros((T, D), jnp.float32).at[row_tok].add(yb.astype(jnp.float32) * row_w[:, None])
    return y.astype(h.dtype).reshape(B, S, D)


def setup_inputs(seed: int = 0) -> dict:
    key = jax.random.key(seed)
    ks = jax.random.split(key, 24)
    D, L = D_MODEL, DEPTH
    nrm = lambda k, shape, s: jax.random.normal(k, shape, jnp.float32) * s
    return {
        "x": nrm(ks[0], (BATCH, SEQ, D), 1.0),
        "c": nrm(ks[1], (BATCH, D), 1.0),
        "w_mod": nrm(ks[2], (L, D, N_MOD * D), D ** -0.5),
        "b_mod": nrm(ks[3], (L, N_MOD * D), 0.02),
        "g_pre_mix": 1.0 + nrm(ks[4], (L, D), 0.05),
        "g_post_mix": 1.0 + nrm(ks[5], (L, D), 0.05),
        "w_in": nrm(ks[6], (L, D, IN_W), D ** -0.5),
        "b_in": nrm(ks[7], (L, IN_W), 0.02),
        "attn_sinks": nrm(ks[8], (L, N_Q_HEADS), 1.0),
        "w_pool_mix": nrm(ks[9], (L, N_POOL_GROUPS, POOL_GC, POOL_GC), POOL_GC ** -0.5),
        "pool_scale": 1.0 + nrm(ks[10], (L, POOL_W), 0.1),
        "w_attn_branch": nrm(ks[11], (L, Q_W, D), Q_W ** -0.5),
        "w_pool_branch": nrm(ks[12], (L, POOL_W, D), POOL_W ** -0.5),
        "w_out": nrm(ks[13], (L, D, D), D ** -0.5),
        "g_pre_ffn": 1.0 + nrm(ks[14], (L, D), 0.05),
        "g_post_ffn": 1.0 + nrm(ks[15], (L, D), 0.05),
        "w_router": nrm(ks[16], (L, D, N_EXPERTS), D ** -0.5),
        "b_router": nrm(ks[17], (L, N_EXPERTS), 0.01),
        "w_gate_up": nrm(ks[18], (L, N_EXPERTS, D, 2 * D_FF), D ** -0.5),
        "b_gate_up": nrm(ks[19], (L, N_EXPERTS, 2 * D_FF), 0.02),
        "w_down": nrm(ks[20], (L, N_EXPERTS, D_FF, D), D_FF ** -0.5),
        "b_down": nrm(ks[21], (L, N_EXPERTS, D), 0.02),
    }


def reference(x, c, w_mod, b_mod, g_pre_mix, g_post_mix, w_in, b_in, attn_sinks,
              w_pool_mix, pool_scale, w_attn_branch, w_pool_branch, w_out,
              g_pre_ffn, g_post_ffn, w_router, b_router, w_gate_up, b_gate_up,
              w_down, b_down):
    B, S, D = x.shape
    split_pts = [Q_W, Q_W + KV_W, Q_W + 2 * KV_W, Q_W + 2 * KV_W + POOL_W]
    for l in range(DEPTH):
        mod = jax.nn.silu(c) @ w_mod[l] + b_mod[l]
        shift_a, scale_a, gate_a, shift_f, scale_f, gate_f = [
            m[:, None, :] for m in jnp.split(mod, N_MOD, axis=-1)]

        h = rms_norm(x, g_pre_mix[l]) * (1.0 + scale_a) + shift_a
        proj = h @ w_in[l] + b_in[l]
        q, k, v, u, gate_logits = jnp.split(proj, split_pts, axis=-1)
        a = sliding_window_sink_attention(q, k, v, attn_sinks[l])
        pg = multiscale_causal_pool(u).reshape(B, S, N_POOL_GROUPS, POOL_GC)
        p = jnp.einsum('bsgc,gcd->bsgd', pg, w_pool_mix[l]).reshape(B, S, POOL_W) * pool_scale[l]
        gates = jax.nn.sigmoid(gate_logits).reshape(B, S, N_BRANCHES, D)
        merged = gates[:, :, 0] * (a @ w_attn_branch[l]) + gates[:, :, 1] * (p @ w_pool_branch[l])
        mix_out = merged @ w_out[l]
        x = x + gate_a * rms_norm(mix_out, g_post_mix[l])

        h = rms_norm(x, g_pre_ffn[l]) * (1.0 + scale_f) + shift_f
        y = moe_ffn(h, w_router[l], b_router[l], w_gate_up[l], b_gate_up[l], w_down[l], b_down[l])
        x = x + gate_f * rms_norm(y, g_post_ffn[l])
    return x
```

```cpp
#include <hip/hip_runtime.h>
#include <hip/hip_bf16.h>
#include <cstdio>
#include <cstdint>

#ifndef MK_N_LAUNCHES
#define MK_N_LAUNCHES 1
#endif

constexpr int T = 8192, D = 2048, SEQ = 4096, INW = 6656, NE = 32, DFF = 2048;
constexpr int NPHASE = 11;
constexpr int HS = 2048 + 64;
constexpr float RMS_EPS = 1e-6f;
constexpr float LOG2E = 1.4426950408889634f;

#define LAS __attribute__((address_space(3)))
typedef unsigned short bf16_t;
typedef short bf16x8 __attribute__((ext_vector_type(8)));
typedef float f32x4 __attribute__((ext_vector_type(4)));
typedef float f32x2 __attribute__((ext_vector_type(2)));
typedef unsigned u32x4 __attribute__((ext_vector_type(4)));
typedef unsigned u32x2 __attribute__((ext_vector_type(2)));
typedef __bf16 bf16x2_t __attribute__((ext_vector_type(2)));

#define XB_TMO      128
#define XB_XCNT(j)  (256  + 64 * (j))
#define XB_XSUB(j)  (1280 + 64 * (j))
#define XB_XGEN(j)  (2304 + 64 * (j))
#define XB_TOP      3328
#define XB_TOPGEN   3392
#define XCD_BAR_WORDS 3456
#define XB_SPIN_CAP (1u << 18)

__device__ __forceinline__ unsigned xb_ld(unsigned* p)              { return __hip_atomic_load(p, __ATOMIC_RELAXED, __HIP_MEMORY_SCOPE_AGENT); }
__device__ __forceinline__ unsigned xb_add(unsigned* p, unsigned v) { return __hip_atomic_fetch_add(p, v, __ATOMIC_RELAXED, __HIP_MEMORY_SCOPE_AGENT); }
__device__ __forceinline__ unsigned xb_xcc_id() { return (unsigned)__builtin_amdgcn_s_getreg((3 << 11) | 20) & 0xFu; }
#define XB_SPIN(cond, bar) do { unsigned _sp = 0; while (cond) { __builtin_amdgcn_s_sleep(1); \
    if ((++_sp & 255u) == 0u) { if (xb_ld(&(bar)[XB_TMO])) break; if (_sp > XB_SPIN_CAP) { atomicAdd(&(bar)[XB_TMO], 1u); break; } } } } while (0)

struct XcdBarrier { unsigned* bar; unsigned x; volatile LAS unsigned* st; };

__device__ __forceinline__ XcdBarrier xcd_barrier_post(unsigned* bar, volatile LAS unsigned* st) {
    XcdBarrier b; b.bar = bar; b.x = xb_xcc_id(); b.st = st;
    if (threadIdx.x == 0) (void)xb_add(&bar[XB_XCNT(b.x)], 1u);
    return b;
}
__device__ __forceinline__ void xcd_barrier_complete(unsigned* bar, unsigned x, unsigned& nloc, unsigned& nx) {
    const unsigned G = gridDim.x * gridDim.y * gridDim.z;
    unsigned sum, cnt, mine, sp = 0u;
    for (;;) {
        sum = 0u; cnt = 0u; mine = 0u;
#pragma unroll
        for (unsigned j = 0; j < 16; ++j) { const unsigned c = xb_ld(&bar[XB_XCNT(j)]); sum += c; cnt += (c > 0u) ? 1u : 0u; mine = (j == x) ? c : mine; }
        if (sum == G) break;
        __builtin_amdgcn_s_sleep(1);
        if ((++sp & 255u) == 0u) { if (xb_ld(&bar[XB_TMO])) break; if (sp > XB_SPIN_CAP) { atomicAdd(&bar[XB_TMO], 1u); break; } }
    }
    nloc = mine > 0u ? mine : 1u; nx = cnt > 0u ? cnt : 1u;
}
__device__ __forceinline__ void xcd_barrier(const XcdBarrier& b) {
    asm volatile("s_waitcnt vmcnt(0)" ::: "memory");
    __syncthreads();
    if (threadIdx.x == 0) {
        unsigned* bar = b.bar;
        __builtin_amdgcn_s_waitcnt(0);
        unsigned nloc = b.st[0], nx = b.st[1];
        if (nloc == 0u) { xcd_barrier_complete(bar, b.x, nloc, nx); b.st[0] = nloc; b.st[1] = nx; }
        const unsigned old = xb_add(&bar[XB_XSUB(b.x)], 1u);
        const unsigned gen = old / nloc;
        if (old + 1u == (gen + 1u) * nloc) {
            __builtin_amdgcn_fence(__ATOMIC_RELEASE, "agent");
            asm volatile("s_waitcnt vmcnt(0)" ::: "memory");
            const unsigned og = xb_add(&bar[XB_TOP], 1u);
            const unsigned tg = og / nx;
            if (og + 1u == (tg + 1u) * nx) xb_add(&bar[XB_TOPGEN], 1u);
            else XB_SPIN(xb_ld(&bar[XB_TOPGEN]) == tg, bar);
            __builtin_amdgcn_fence(__ATOMIC_ACQUIRE, "agent");
            xb_add(&bar[XB_XGEN(b.x)], 1u);
            asm volatile("s_waitcnt vmcnt(0)" ::: "memory");
        } else {
            XB_SPIN(xb_ld(&bar[XB_XGEN(b.x)]) == gen, bar);
            __builtin_amdgcn_fence(__ATOMIC_ACQUIRE, "agent");
            asm volatile("s_waitcnt vmcnt(0)" ::: "memory");
        }
    }
    __syncthreads();
}

constexpr size_t al256(size_t x) { return (x + 255) & ~(size_t)255; }
constexpr size_t WS_CTL   = 0;
constexpr size_t CTL_BYTES = 65536;
constexpr size_t CTL_CNT_OFF = 16384;
constexpr size_t CTL_RANK_OFF = 32768;
constexpr size_t CTL_TICKET_OFF = 49152;
constexpr size_t CTL_FLAG_OFF = 53248;
constexpr size_t WS_MOD   = WS_CTL + CTL_BYTES;
constexpr size_t WS_WRT   = al256(WS_MOD + 2 * 12288 * 4);
constexpr size_t WS_WMS   = al256(WS_WRT + 32 * 2048 * 2);
constexpr size_t WS_H     = al256(WS_WMS + 4 * 256 * 256 * 2);
constexpr size_t WS_PROJ  = al256(WS_H + (size_t)T * HS * 2);
constexpr size_t WS_VT    = al256(WS_PROJ + (size_t)T * INW * 2);
constexpr size_t WS_ATT   = al256(WS_VT + (size_t)2 * 4 * 64 * SEQ * 2);
constexpr size_t WS_PG    = al256(WS_ATT + (size_t)T * 1024 * 2);
constexpr size_t WS_PP    = al256(WS_PG + (size_t)T * 1024 * 2);
constexpr size_t WS_MRGF  = al256(WS_PP + (size_t)T * 1024 * 2);
constexpr size_t WS_MRG   = al256(WS_MRGF + (size_t)T * D * 4);
constexpr size_t WS_MIX   = al256(WS_MRG + (size_t)T * D * 2);
constexpr size_t WS_LTOK  = al256(WS_MIX + (size_t)T * D * 4);
constexpr size_t WS_LW    = al256(WS_LTOK + (size_t)NE * T * 4);
constexpr size_t WS_TSLOT = al256(WS_LW + (size_t)NE * T * 4);
constexpr int    NPADROWS = T * 4 + NE * 256;
constexpr size_t WS_ACT   = al256(WS_TSLOT + (size_t)T * 4 * 4);
constexpr size_t WS_YB    = al256(WS_ACT + (size_t)NPADROWS * DFF * 2);
constexpr size_t WS_YB2   = al256(WS_YB + (size_t)NPADROWS * D * 2);
constexpr size_t WS_WBIN  = al256(WS_YB2 + (size_t)NPADROWS * D * 2);
constexpr size_t WS_WBA   = al256(WS_WBIN + (size_t)D * INW * 2);
constexpr size_t WS_WBO   = al256(WS_WBA + (size_t)1024 * D * 2);
constexpr size_t WS_END   = al256(WS_WBO + (size_t)D * D * 2);

constexpr int LDS_BAR  = 0;
constexpr int LDS_MAIN = 1024;
constexpr int LDS_A0 = LDS_MAIN, LDS_B0 = LDS_MAIN + 65536;
constexpr int LDS_TAB  = LDS_MAIN + 132096;
constexpr int LDS_BYTES = LDS_TAB + 4096;

struct Args {
    const float* in[22];
    float* out;
    unsigned char* ws;
    int ph_lo, ph_hi;
};

__device__ __forceinline__ unsigned pk_bf16(float lo, float hi) { f32x2 v = {lo, hi}; bf16x2_t b = __builtin_convertvector(v, bf16x2_t); return __builtin_bit_cast(unsigned, b); }
__device__ __forceinline__ float bf_lo(unsigned u) { return __uint_as_float(u << 16); }
__device__ __forceinline__ float bf_hi(unsigned u) { return __uint_as_float(u & 0xffff0000u); }
__device__ __forceinline__ float wave_sum(float v) {
#pragma unroll
    for (int o = 32; o >= 1; o >>= 1) v += __shfl_xor(v, o);
    return v;
}
__device__ __forceinline__ int swz(int r) { return (((r >> 1) ^ (r >> 4)) & 1) | (((r >> 2) & 1) << 1) | ((((r >> 3) ^ (r >> 5)) & 1) << 2); }

struct Wv { int tid, wid, lane, wm, wn, lr, lq; unsigned offA0, offB0, bw0, aw0; };

__device__ __forceinline__ void wv_init(Wv& w, int perm = 0) {
    w.tid = threadIdx.x; asm volatile("" : "+v"(w.tid));
    w.lane = w.tid & 63; w.wid = __builtin_amdgcn_readfirstlane(w.tid >> 6);
    w.wm = w.wid >> 2; w.wn = w.wid & 3; w.lr = w.lane & 15; w.lq = w.lane >> 4;
    const int v = w.lq ^ (w.lr >> 1);
    w.offA0 = (unsigned)((w.wm * 128 + w.lr) * 128 + (v << 4));
    w.offB0 = (unsigned)((w.wn * 64 + w.lr) * 128 + (v << 4));
    const int l = w.lane; const int rho = perm ? 64 * (l >> 4) + 32 * ((l >> 3) & 1) + 16 * (l & 1) + 4 * ((l >> 1) & 3) : 64 * (l >> 4) + 16 * (l & 3) + 4 * ((l >> 2) & 3);
    w.bw0 = (unsigned)(rho * 128 + ((w.wid ^ swz(rho)) << 4));
    { const int r0 = w.wid * 8 + (l >> 3); w.aw0 = (unsigned)(r0 * 128 + (((l & 7) ^ swz(r0)) << 4)); }
}
__device__ __forceinline__ int dma_row(const Wv& w, int p) { return p * 64 + w.wid * 8 + (w.lane >> 3); }
__device__ __forceinline__ int dma_chunk(const Wv& w, int p) { (void)p; return (w.lane & 7); }

#define KAPX(i, ks) (((((ks) << 2) ^ (((i) & 1) | (((i) & 2) << 1)))) << 4)

typedef int i32x4 __attribute__((ext_vector_type(4)));
__device__ __forceinline__ i32x4 mk_desc(const void* p, unsigned bytes) { const unsigned long long a = (unsigned long long)p; i32x4 d; d.x = __builtin_amdgcn_readfirstlane((int)(unsigned)a); d.y = __builtin_amdgcn_readfirstlane((int)((unsigned)(a >> 32) & 0xffffu)); d.z = __builtin_amdgcn_readfirstlane((int)bytes); d.w = 0x00020000; return d; }
__device__ __forceinline__ __amdgpu_buffer_rsrc_t mk_rsrc(const void* p, unsigned bytes) { return __builtin_amdgcn_make_buffer_rsrc((void*)p, (short)0, (int)bytes, 0x00020000); }

struct LoadDesc {
    const void* Ap; unsigned Abytes; unsigned arow[4]; int apitch64;
    const void* Wp; unsigned Wbytes; unsigned bvoff; int ldwb;
    int nkt;
    int nvalid;
};
template <class Sched, bool GATHER = false, bool WBF16 = false>
__device__ __forceinline__ void gemm_stream(LAS unsigned char* lds, const Sched& S) {
    typedef typename Sched::Epi Epi;
    Wv w; wv_init(w, Epi::PERM);
    LoadDesc cur, nxt; Epi ecur, enxt;
    if (!S.next(0, w, cur, ecur)) return;
    int ui = 1; bool has_nxt = S.next(1, w, nxt, enxt);
    f32x4 acc[8][4];
    f32x4 breg[WBF16 ? 1 : 8]; u32x2 bhr[WBF16 ? 8 : 1];
    u32x4 areg[4];
    bf16x8 afr[8], bfr[4];
    const int half = w.wm;
#define G_BAR() asm volatile("s_barrier" ::: "memory")
#define G_LGKM0() asm volatile("s_waitcnt lgkmcnt(0)" ::: "memory")
#define G_LDSEL(t2) const bool sel_ = ((t2) >= cur.nkt) && has_nxt; const int kt_ = ((t2) >= cur.nkt) ? (t2) - cur.nkt : (t2);
#define G_LDA(t2, h) do { G_LDSEL(t2) \
        const __amdgpu_buffer_rsrc_t ars_ = mk_rsrc(sel_ ? nxt.Ap : cur.Ap, sel_ ? nxt.Abytes : cur.Abytes); const int ap64_ = sel_ ? nxt.apitch64 : cur.apitch64; (void)ap64_; \
        _Pragma("unroll") for (int q = 0; q < 2; ++q) { const int p = 2 * (h) + q; const unsigned av_ = GATHER ? (sel_ ? nxt.arow[p] : cur.arow[p]) : (sel_ ? nxt.arow[0] : cur.arow[0]); \
            areg[p] = __builtin_bit_cast(u32x4, __builtin_amdgcn_raw_buffer_load_b128(ars_, av_, GATHER ? kt_ * 128 : kt_ * 128 + p * ap64_, 0)); } } while (0)
#define G_LDA1(t2, h, q) do { G_LDSEL(t2) \
        const __amdgpu_buffer_rsrc_t ars_ = mk_rsrc(sel_ ? nxt.Ap : cur.Ap, sel_ ? nxt.Abytes : cur.Abytes); const int ap64_ = sel_ ? nxt.apitch64 : cur.apitch64; (void)ap64_; \
        { const int p = 2 * (h) + (q); const unsigned av_ = GATHER ? (sel_ ? nxt.arow[p] : cur.arow[p]) : (sel_ ? nxt.arow[0] : cur.arow[0]); \
            areg[p] = __builtin_bit_cast(u32x4, __builtin_amdgcn_raw_buffer_load_b128(ars_, av_, GATHER ? kt_ * 128 : kt_ * 128 + p * ap64_, 0)); } } while (0)
#define G_LDB(t2, h, j0, j1) do { G_LDSEL(t2) \
        const __amdgpu_buffer_rsrc_t wrs_ = mk_rsrc(sel_ ? nxt.Wp : cur.Wp, sel_ ? nxt.Wbytes : cur.Wbytes); const int ldwb_ = sel_ ? nxt.ldwb : cur.ldwb; const unsigned bvo_ = sel_ ? nxt.bvoff : cur.bvoff; \
        _Pragma("unroll") for (int j = (j0); j < (j1); ++j) { if constexpr (WBF16) bhr[4 * (h) + j] = __builtin_bit_cast(u32x2, __builtin_amdgcn_raw_buffer_load_b64(wrs_, bvo_, (kt_ * 64 + 4 * (h) + j) * ldwb_, 0)); \
            else breg[4 * (h) + j] = __builtin_bit_cast(f32x4, __builtin_amdgcn_raw_buffer_load_b128(wrs_, bvo_, (kt_ * 64 + 4 * (h) + j) * ldwb_, 0)); } } while (0)
#define G_LD(t2, h) do { G_LDA(t2, h); G_LDB(t2, h, 0, 4); } while (0)
#define G_FENCE() asm volatile("" ::: "memory")
#define G_AWR(buf, h) do { _Pragma("unroll") for (int q = 0; q < 2; ++q) { const int p = 2 * (h) + q; \
        *(LAS u32x4*)(lds + LDS_A0 + (buf) * 32768 + w.aw0 + p * 8192) = areg[p]; } } while (0)
#define G_BWR(buf, h) do { _Pragma("unroll") for (int c = 0; c < 4; ++c) { u32x2 v_; \
        if constexpr (WBF16) { const unsigned sl_ = (c & 1) ? 0x07060302u : 0x05040100u; \
            v_.x = __builtin_amdgcn_perm(bhr[4 * (h) + 1][c >> 1], bhr[4 * (h)][c >> 1], sl_); v_.y = __builtin_amdgcn_perm(bhr[4 * (h) + 3][c >> 1], bhr[4 * (h) + 2][c >> 1], sl_); } \
        else { v_.x = pk_bf16(breg[WBF16 ? 0 : 4 * (h)][c], breg[WBF16 ? 0 : 4 * (h) + 1][c]); v_.y = pk_bf16(breg[WBF16 ? 0 : 4 * (h) + 2][c], breg[WBF16 ? 0 : 4 * (h) + 3][c]); } \
        *(LAS u32x2*)(lds + LDS_B0 + (buf) * 32768 + (w.bw0 ^ ((c >> 1) << 4)) + c * 128 + 8 * (h)) = v_; } } while (0)
#define G_FRAGB(buf, ks) do { \
        _Pragma("unroll") for (int j = 0; j < 4; ++j) bfr[j] = *(const LAS bf16x8*)(lds + LDS_B0 + (buf) * 32768 + (w.offB0 ^ KAPX(j, ks)) + j * 2048); \
        afr[0] = *(const LAS bf16x8*)(lds + LDS_A0 + (buf) * 32768 + (w.offA0 ^ KAPX(0, ks))); } while (0)
#define G_FRAGA(buf, ks) do { \
        _Pragma("unroll") for (int i = 1; i < 8; ++i) afr[i] = *(const LAS bf16x8*)(lds + LDS_A0 + (buf) * 32768 + (w.offA0 ^ KAPX(i, ks)) + i * 2048); } while (0)
#define G_MMAR(i0, i1) do { if (ni) { _Pragma("unroll") for (int i = (i0); i < (i1); ++i) _Pragma("unroll") for (int j = 0; j < 4; ++j) \
        asm volatile("v_mfma_f32_16x16x32_bf16 %0, %1, %2, %0" : "+v"(acc[i][j]) : "v"(bfr[j]), "v"(afr[i])); } } while (0)
#define G_MMA0R(i0, i1) do { if (ni) { _Pragma("unroll") for (int i = (i0); i < (i1); ++i) _Pragma("unroll") for (int j = 0; j < 4; ++j) \
        asm volatile("v_mfma_f32_16x16x32_bf16 %0, %1, %2, 0" : "=v"(acc[i][j]) : "v"(bfr[j]), "v"(afr[i])); } } while (0)
#define G_MSEG(MM, t2, h) do { MM(0, 1); G_FENCE(); G_LDA1(t2, h, 0); G_FENCE(); MM(1, 2); G_FENCE(); G_LDA1(t2, h, 1); G_FENCE(); MM(2, 3); G_FENCE(); G_LDB(t2, h, 0, 1); G_FENCE(); MM(3, 4); G_FENCE(); G_LDB(t2, h, 1, 2); G_FENCE(); MM(4, 5); G_FENCE(); G_LDB(t2, h, 2, 3); G_FENCE(); MM(5, 6); G_FENCE(); G_LDB(t2, h, 3, 4); G_FENCE(); MM(6, 8); } while (0)
#define G_TILE0() do { \
          G_FRAGB(0, 0); G_AWR(1, 0); G_BWR(1, 0); G_FRAGA(0, 0); G_LGKM0(); G_BAR(); \
          G_MSEG(G_MMA0R, 2, 0); G_BAR(); \
          G_FRAGB(0, 1); G_AWR(1, 1); G_BWR(1, 1); G_FRAGA(0, 1); G_LGKM0(); G_BAR(); \
          G_MSEG(G_MMAR, 2, 1); G_BAR(); } while (0)
#define G_TILE(t, b) do { \
          G_FRAGB(b, 0); G_AWR((b) ^ 1, 0); G_BWR((b) ^ 1, 0); G_FRAGA(b, 0); G_LGKM0(); G_BAR(); \
          G_MSEG(G_MMAR, (t) + 2, 0); G_BAR(); \
          G_FRAGB(b, 1); G_AWR((b) ^ 1, 1); G_BWR((b) ^ 1, 1); G_FRAGA(b, 1); G_LGKM0(); G_BAR(); \
          G_MSEG(G_MMAR, (t) + 2, 1); G_BAR(); } while (0)
#define G_TILEX(t, b, skip) do { \
          G_FRAGB(b, 0); G_AWR((b) ^ 1, 0); G_BWR((b) ^ 1, 0); G_FRAGA(b, 0); G_LGKM0(); G_BAR(); \
          G_MSEG(G_MMAR, (t) + 2, 0); G_BAR(); \
          G_FRAGB(b, 1); G_AWR((b) ^ 1, 1); G_BWR((b) ^ 1, 1); G_FRAGA(b, 1); G_LGKM0(); G_BAR(); \
          G_MSEG(G_MMAR, (t) + 2, 1); if (!(skip)) G_BAR(); } while (0)

    G_LD(0, 0); G_LD(0, 1);
    G_AWR(0, 0); G_AWR(0, 1); G_BWR(0, 0); G_BWR(0, 1);
    G_LD(1, 0); G_LD(1, 1);
    G_LGKM0(); G_BAR();
    if (half == 1) G_BAR();
    if (half == 1) asm volatile("s_setprio 1");
#pragma unroll 1
    for (;;) {
        int ni = 1; if constexpr (Sched::ROWSKIP) ni = __builtin_amdgcn_readfirstlane((cur.nvalid > half * 128) ? 1 : 0);
        G_TILE0(); G_TILE(1, 1);
#pragma unroll 1
        for (int t = 2; t < cur.nkt; t += 2) { G_TILE(t, 0); G_TILEX(t + 1, 1, (half == 1) && (t + 2 >= cur.nkt)); }
        asm volatile("s_nop 15\n\ts_nop 15\n\ts_nop 15" ::: "memory");
        ecur(acc, w);
        if (!has_nxt) break;
        cur = nxt; ecur = enxt; ++ui; has_nxt = S.next(ui, w, nxt, enxt);
        if (half == 1) G_BAR();
    }
    asm volatile("s_setprio 0");
    __syncthreads();
#undef G_BAR
#undef G_LGKM0
#undef G_LD
#undef G_AWR
#undef G_BWR
#undef G_FRAGB
#undef G_FRAGA
#undef G_MMAR
#undef G_MMA0R
#undef G_MSEG
#undef G_LDA
#undef G_LDA1
#undef G_LDB
#undef G_LDSEL
#undef G_FENCE
#undef G_TILE0
#undef G_TILE
#undef G_TILEX
}

struct LaneXY { int lr, lq, wm, wn; };
__device__ __forceinline__ LaneXY opaque_xy(const Wv& w) { LaneXY q; int l = w.lane; asm volatile("" : "+v"(l)); q.lr = l & 15; q.lq = l >> 4; q.wm = w.wm; q.wn = w.wn; return q; }
#define PCOL(j, lq) (32 * ((j) >> 1) + 8 * (lq) + 4 * ((j) & 1))
__device__ __forceinline__ void st_row_bf16(bf16_t* rowp  , int lq, const f32x4& a0, const f32x4& a1, const f32x4& a2, const f32x4& a3) {
    u32x4 o0, o1; o0.x = pk_bf16(a0[0], a0[1]); o0.y = pk_bf16(a0[2], a0[3]); o0.z = pk_bf16(a1[0], a1[1]); o0.w = pk_bf16(a1[2], a1[3]);
    o1.x = pk_bf16(a2[0], a2[1]); o1.y = pk_bf16(a2[2], a2[3]); o1.z = pk_bf16(a3[0], a3[1]); o1.w = pk_bf16(a3[2], a3[3]);
    *(u32x4*)(rowp + 8 * lq) = o0; *(u32x4*)(rowp + 32 + 8 * lq) = o1;
}
struct EpiProj {
    static constexpr int PERM = 1;
    bf16_t* proj; bf16_t* vt; const float* bias; int m0, n0;
    __device__ __forceinline__ void operator()(f32x4 (&acc)[8][4], const Wv& w0) const { const LaneXY w = opaque_xy(w0);
        const int colw = n0 + w.wn * 64;
        f32x4 bv[4];
#pragma unroll
        for (int j = 0; j < 4; ++j) bv[j] = *(const f32x4*)(bias + colw + PCOL(j, w.lq));
        if (n0 == 1280) {
#pragma unroll
            for (int i = 0; i < 8; ++i) { const int row = m0 + w.wm * 128 + i * 16 + w.lr; const int b = row >> 12, sq = row & 4095;
#pragma unroll
                for (int j = 0; j < 4; ++j)
#pragma unroll
                    for (int e = 0; e < 4; ++e) { const int d = PCOL(j, w.lq) + e; const float v = acc[i][j][e] + bv[j][e];
                        vt[((size_t)((b * 4 + w.wn) * 64 + d)) * SEQ + sq] = (bf16_t)(pk_bf16(v, 0.f) & 0xffffu); } }
            return;
        }
        const float qs = (n0 < 1024) ? 0.125f * LOG2E : 1.0f;
        const bool sig = n0 >= 2560;
#pragma unroll
        for (int i = 0; i < 8; ++i) { const int row = m0 + w.wm * 128 + i * 16 + w.lr;
            f32x4 v[4];
#pragma unroll
            for (int j = 0; j < 4; ++j)
#pragma unroll
                for (int e = 0; e < 4; ++e) { float x = (acc[i][j][e] + bv[j][e]) * qs; if (sig) x = __builtin_amdgcn_rcpf(1.0f + __builtin_amdgcn_exp2f(-LOG2E * x)); v[j][e] = x; }
            st_row_bf16(proj + (size_t)row * INW + colw, w.lq, v[0], v[1], v[2], v[3]); }
    }
};
struct EpiWc {
    static constexpr int PERM = 1;
    bf16_t* wc; int r0, n0;
    __device__ __forceinline__ void operator()(f32x4 (&acc)[8][4], const Wv& w0) const { const LaneXY w = opaque_xy(w0);
        const int colw = n0 + w.wn * 64;
#pragma unroll
        for (int i = 0; i < 8; ++i) { const int row = r0 + w.wm * 128 + i * 16 + w.lr; st_row_bf16(wc + (size_t)row * D + colw, w.lq, acc[i][0], acc[i][1], acc[i][2], acc[i][3]); }
    }
};
struct EpiBranch {
    static constexpr int PERM = 1;
    bf16_t* part; bf16_t* mrg; const bf16_t* proj; int m0, n0, second;
    __device__ __forceinline__ void operator()(f32x4 (&acc)[8][4], const Wv& w0) const { const LaneXY w = opaque_xy(w0);
        const int colw = n0 + w.wn * 64;
        if (second) asm volatile("s_waitcnt vmcnt(0)" ::: "memory");
#pragma unroll
        for (int i = 0; i < 8; ++i) { const int row = m0 + w.wm * 128 + i * 16 + w.lr;
            const bf16_t* gp = proj + (size_t)row * INW + 2560 + second * 2048 + colw;
            const u32x4 g0 = *(const u32x4*)(gp + 8 * w.lq), g1 = *(const u32x4*)(gp + 32 + 8 * w.lq);
            const unsigned gw[8] = {g0.x, g0.y, g0.z, g0.w, g1.x, g1.y, g1.z, g1.w};
            f32x4 r[4];
#pragma unroll
            for (int j = 0; j < 4; ++j) { f32x4 g = {bf_lo(gw[2 * j]), bf_hi(gw[2 * j]), bf_lo(gw[2 * j + 1]), bf_hi(gw[2 * j + 1])}; r[j] = acc[i][j] * g; }
            bf16_t* pp_ = part + (size_t)row * D + colw;
            if (second == 0) { st_row_bf16(pp_, w.lq, r[0], r[1], r[2], r[3]); }
            else {
                const u32x4 p0 = *(const u32x4*)(pp_ + 8 * w.lq), p1 = *(const u32x4*)(pp_ + 32 + 8 * w.lq);
                const unsigned pw[8] = {p0.x, p0.y, p0.z, p0.w, p1.x, p1.y, p1.z, p1.w};
#pragma unroll
                for (int j = 0; j < 4; ++j) { r[j][0] += bf_lo(pw[2 * j]); r[j][1] += bf_hi(pw[2 * j]); r[j][2] += bf_lo(pw[2 * j + 1]); r[j][3] += bf_hi(pw[2 * j + 1]); }
                st_row_bf16(mrg + (size_t)row * D + colw, w.lq, r[0], r[1], r[2], r[3]);
            } }
    }
};
struct EpiOut {
    static constexpr int PERM = 1;
    bf16_t* mix; int m0, n0;
    __device__ __forceinline__ void operator()(f32x4 (&acc)[8][4], const Wv& w0) const { const LaneXY w = opaque_xy(w0);
        const int colw = n0 + w.wn * 64;
#pragma unroll
        for (int i = 0; i < 8; ++i) { const int row = m0 + w.wm * 128 + i * 16 + w.lr; st_row_bf16(mix + (size_t)row * D + colw, w.lq, acc[i][0], acc[i][1], acc[i][2], acc[i][3]); }
    }
};
struct EpiSwiglu {
    static constexpr int PERM = 0;
    bf16_t* act; const float* bias; int orow0, n0;
    __device__ __forceinline__ void operator()(f32x4 (&acc)[8][4], const Wv& w0) const { const LaneXY w = opaque_xy(w0);
        const int colb = n0 + w.wn * 64 + 16 * w.lq;
        f32x4 bv[4];
#pragma unroll
        for (int j = 0; j < 4; ++j) bv[j] = *(const f32x4*)(bias + colb + 4 * j);
#pragma unroll
        for (int i = 0; i < 8; ++i) { const int row = orow0 + w.wm * 128 + i * 16 + w.lr;
            float o[8];
#pragma unroll
            for (int j = 0; j < 4; ++j)
#pragma unroll
                for (int h = 0; h < 2; ++h) { float xg = acc[i][j][2 * h] + bv[j][2 * h], xl = acc[i][j][2 * h + 1] + bv[j][2 * h + 1];
                    xg = fminf(xg, 7.0f); xl = fminf(fmaxf(xl, -7.0f), 7.0f);
                    o[2 * j + h] = xg * __builtin_amdgcn_rcpf(1.0f + __builtin_amdgcn_exp2f((-1.702f * LOG2E) * xg)) * (xl + 1.0f); }
            u32x4 ov; ov.x = pk_bf16(o[0], o[1]); ov.y = pk_bf16(o[2], o[3]); ov.z = pk_bf16(o[4], o[5]); ov.w = pk_bf16(o[6], o[7]);
            *(u32x4*)(act + (size_t)row * DFF + (colb >> 1)) = ov; }
    }
};
struct EpiDown {
    static constexpr int PERM = 1;
    bf16_t* yb; const float* bias; const float* lw; int orow0, n0, s0, cnt; float bsc;
    __device__ __forceinline__ void operator()(f32x4 (&acc)[8][4], const Wv& w0) const { const LaneXY w = opaque_xy(w0);
        const int colw = n0 + w.wn * 64;
        f32x4 bv[4];
#pragma unroll
        for (int j = 0; j < 4; ++j) bv[j] = *(const f32x4*)(bias + colw + PCOL(j, w.lq)) * bsc;
#pragma unroll
        for (int i = 0; i < 8; ++i) { const int r = w.wm * 128 + i * 16 + w.lr; const int sl = s0 + r; const float rw = (sl < cnt) ? lw[sl] : 0.f;
            if (sl < cnt) st_row_bf16(yb + (size_t)(orow0 + r) * D + colw, w.lq, (acc[i][0] + bv[0]) * rw, (acc[i][1] + bv[1]) * rw, (acc[i][2] + bv[2]) * rw, (acc[i][3] + bv[3]) * rw); }
    }
};

__device__ __forceinline__ void moe_tables(LAS unsigned char* lds, const unsigned* cntg) {
    LAS int* tab = (LAS int*)(lds + LDS_TAB);
    const int t = threadIdx.x;
    if (t < 64) {
        const int c = (t < 32) ? (int)cntg[16 * (t & 31)] : 0; const int nt = (c + 255) >> 8;
        int incl = nt;
#pragma unroll
        for (int o = 1; o < 32; o <<= 1) { const int v = __shfl_up(incl, o, 64); if (t >= o) incl += v; }
        if (t < 32) { tab[t] = c; tab[32 + t] = nt; tab[64 + t] = incl - nt; }
        if (t == 31) tab[96] = incl; }
    __syncthreads();
}
__device__ __forceinline__ void moe_decode(LAS unsigned char* lds, int u, int NN, int& e, int& ti, int& pn) {
    const LAS int* tab = (const LAS int*)(lds + LDS_TAB);
    const int ln = (int)(threadIdx.x & 63u);
    const bool past = (ln < 32) && (u >= tab[64 + ln + 1] * NN);
    int ee = __builtin_popcountll(__ballot(past)); if (ee > 31) ee = 31;
    const int rem = u - tab[64 + ee] * NN, nt = tab[32 + ee];
    const int pn_ = rem / nt;
    e = __builtin_amdgcn_readfirstlane(ee); pn = __builtin_amdgcn_readfirstlane(pn_); ti = __builtin_amdgcn_readfirstlane(rem - pn_ * nt);
}

__device__ __forceinline__ void ld_dense(LoadDesc& L, const Wv& w, const void* Ap, unsigned Abytes, int row0, int pitchB, int colB, const void* Wp, unsigned Wbytes, int ldw, int k0, int n0, int nkt, int wes = 4  ) {
    L.Ap = Ap; L.Abytes = Abytes; L.arow[0] = (unsigned)((row0 + dma_row(w, 0)) * pitchB + colB + dma_chunk(w, 0) * 16); L.arow[1] = 0u; L.arow[2] = 0u; L.arow[3] = 0u; L.apitch64 = 64 * pitchB;
    L.Wp = Wp; L.Wbytes = Wbytes; L.bvoff = (unsigned)(((w.wid * 8 + k0) * ldw + n0 + 4 * w.lane) * wes); L.ldwb = ldw * wes; L.nkt = nkt; L.nvalid = 256;
}
struct SchedProj {
    static constexpr bool ROWSKIP = false;
    typedef EpiProj Epi;
    const bf16_t* hbuf; const bf16_t* w_in; bf16_t* proj; bf16_t* vt; const float* b_in; int first, stride, count;
    __device__ __forceinline__ bool next(int i, const Wv& w, LoadDesc& L, Epi& E) const {
        if (i >= count) return false;
        const int u = first + i * stride; const int v = u % 104; const int pm = (u / 104) * 4 + (v & 3), pn = v >> 2; const int m0 = pm * 256, n0 = pn * 256;
        ld_dense(L, w, hbuf, (unsigned)((size_t)T * HS * 2), m0, HS * 2, 0, w_in, (unsigned)((size_t)D * INW * 2), INW, 0, n0, D / 64, 2);
        E = EpiProj{proj, vt, b_in, m0, n0}; return true; }
};
struct SchedWc {
    static constexpr bool ROWSKIP = false;
    typedef EpiWc Epi;
    const bf16_t* wms; const float* w_pool_branch; bf16_t* wc; int g, n0;
    __device__ __forceinline__ bool next(int i, const Wv& w, LoadDesc& L, Epi& E) const {
        if (i >= 1) return false;
        ld_dense(L, w, wms, 4u * 256u * 256u * 2u, g * 256, 512, 0, w_pool_branch + (size_t)g * 256 * D, 256u * 2048u * 4u, D, 0, n0, 4);
        E = EpiWc{wc, g * 256, n0}; return true; }
};
struct SchedBranch {
    static constexpr bool ROWSKIP = false;
    typedef EpiBranch Epi;
    const bf16_t* att; const bf16_t* pg; const bf16_t* w_a; const bf16_t* wc; bf16_t* mrgf; bf16_t* mrg; const bf16_t* proj; int first, stride, count;
    __device__ __forceinline__ bool next(int i, const Wv& w, LoadDesc& L, Epi& E) const {
        if (i >= 2 * count) return false;
        const int u = first + (i >> 1) * stride, second = i & 1; const int v = u & 31; const int pm = (u >> 5) * 4 + (v & 3), pn = v >> 2; const int m0 = pm * 256, n0 = pn * 256;
        ld_dense(L, w, second ? pg : att, (unsigned)((size_t)T * 1024 * 2), m0, 2048, 0, second ? wc : w_a, 1024u * 2048u * 2u, D, 0, n0, 16, 2);
        E = EpiBranch{mrgf, mrg, proj, m0, n0, second}; return true; }
};
struct SchedOut {
    static constexpr bool ROWSKIP = false;
    typedef EpiOut Epi;
    const bf16_t* mrg; const bf16_t* w_out; bf16_t* mix; int first, stride, count;
    __device__ __forceinline__ bool next(int i, const Wv& w, LoadDesc& L, Epi& E) const {
        if (i >= count) return false;
        const int u = first + i * stride; const int v = u & 31; const int pm = (u >> 5) * 4 + (v & 3), pn = v >> 2; const int m0 = pm * 256, n0 = pn * 256;
        ld_dense(L, w, mrg, (unsigned)((size_t)T * D * 2), m0, D * 2, 0, w_out, 2048u * 2048u * 2u, D, 0, n0, D / 64, 2);
        E = EpiOut{mix, m0, n0}; return true; }
};
struct SchedGateUp {
    static constexpr bool ROWSKIP = false;
    typedef EpiSwiglu Epi;
    LAS unsigned char* lds; const bf16_t* hbuf; const int* ltok; const float* w_gate_up; const float* b_gate_up; bf16_t* act; int first, stride, uend;
    __device__ __forceinline__ bool next(int i, const Wv& w, LoadDesc& L, Epi& E) const {
        const int u = first + i * stride; if (u >= uend) return false;
        const LAS int* tab = (const LAS int*)(lds + LDS_TAB);
        int e, ti, pn; moe_decode(lds, u, 16, e, ti, pn);
        const int cnt = __builtin_amdgcn_readfirstlane(tab[e]), s0 = ti * 256, orow0 = __builtin_amdgcn_readfirstlane(tab[64 + e]) * 256 + s0, n0 = pn * 256;
        L.Ap = hbuf; L.Abytes = (unsigned)((size_t)T * HS * 2); L.apitch64 = 0;
        { unsigned tk[4];
#pragma unroll
          for (int p = 0; p < 4; ++p) { const int sl = s0 + dma_row(w, p); tk[p] = (sl < cnt) ? (unsigned)ltok[e * T + sl] * (unsigned)(HS * 2) + (unsigned)((w.lane & 7) * 16) : 0xfffffff0u; }
          L.arow[0] = tk[0]; L.arow[1] = tk[1]; L.arow[2] = tk[2]; L.arow[3] = tk[3]; }
        L.Wp = w_gate_up + (size_t)e * 2048 * 4096; L.Wbytes = 2048u * 4096u * 4u; L.bvoff = (unsigned)(((w.wid * 8) * 4096 + n0 + 4 * w.lane) * 4); L.ldwb = 4096 * 4; L.nkt = D / 64; L.nvalid = (cnt - s0 < 256) ? cnt - s0 : 256;
        E = EpiSwiglu{act, b_gate_up + (size_t)e * 4096, orow0, n0}; return true; }
};
struct SchedDown {
    static constexpr bool ROWSKIP = false;
    typedef EpiDown Epi;
    LAS unsigned char* lds; const bf16_t* act; const float* lw; const float* w_down; const float* b_down; bf16_t* yb; bf16_t* yb2; unsigned char* sflag; int first, stride, nfull, last, lastkh;
    __device__ __forceinline__ bool next(int i, const Wv& w, LoadDesc& L, Epi& E) const {
        if (i > nfull || (i == nfull && last < 0)) return false;
        const bool fin = (i == nfull); const int u = fin ? last : first + i * stride; const int kh = fin ? lastkh : -1;
        const LAS int* tab = (const LAS int*)(lds + LDS_TAB);
        int e, ti, pn; moe_decode(lds, u, 8, e, ti, pn);
        const int cnt = __builtin_amdgcn_readfirstlane(tab[e]), s0 = ti * 256, tile = __builtin_amdgcn_readfirstlane(tab[64 + e]) + ti, orow0 = tile * 256, n0 = pn * 256;
        const int k0 = (kh > 0) ? 1024 : 0;
        ld_dense(L, w, act, (unsigned)((size_t)NPADROWS * DFF * 2), orow0, DFF * 2, k0 * 2, w_down + (size_t)e * 2048 * 2048, 2048u * 2048u * 4u, 2048, k0, n0, (kh >= 0) ? 16 : 32);
        L.nvalid = (cnt - s0 < 256) ? cnt - s0 : 256;
#pragma unroll
        for (int p = 0; p < 4; ++p) { const int r = dma_row(w, p); L.arow[p] = (s0 + r < cnt) ? (unsigned)((orow0 + r) * (DFF * 2) + k0 * 2 + dma_chunk(w, p) * 16) : 0xfffffff0u; }
        L.apitch64 = 0;
        if (kh >= 0 && w.wid == 0 && w.lane == 0) sflag[tile * 8 + pn] = 1;
        E = EpiDown{(kh > 0) ? yb2 : yb, b_down + (size_t)e * 2048, lw + (size_t)e * T, orow0, n0, s0, cnt, (kh > 0) ? 0.f : 1.f}; return true; }
};

template <int WL>
__device__ __forceinline__ void pool_run(const bf16_t* proj, bf16_t* pg, int tok0, int ch) {
    const int tin0 = tok0 & (SEQ - 1);
    const bf16_t* base = proj + (size_t)tok0 * INW + 1536 + ch * 8;
    u32x4 r[WL + 7];
#pragma unroll
    for (int j = 0; j < WL + 7; ++j) { const int d = j - (WL - 1); r[j] = (u32x4){0u, 0u, 0u, 0u}; if (d >= 0 || tin0 + d >= 0) r[j] = *(const u32x4*)(base + (long)d * INW); }
    float s[8];
#pragma unroll
    for (int e = 0; e < 8; ++e) s[e] = 0.f;
#pragma unroll
    for (int j = 0; j < WL; ++j) { s[0] += bf_lo(r[j].x); s[1] += bf_hi(r[j].x); s[2] += bf_lo(r[j].y); s[3] += bf_hi(r[j].y); s[4] += bf_lo(r[j].z); s[5] += bf_hi(r[j].z); s[6] += bf_lo(r[j].w); s[7] += bf_hi(r[j].w); }
#pragma unroll
    for (int t = 0; t < 8; ++t) {
        if (t > 0) { const u32x4 a = r[WL - 1 + t], b = r[t - 1];
            s[0] += bf_lo(a.x) - bf_lo(b.x); s[1] += bf_hi(a.x) - bf_hi(b.x); s[2] += bf_lo(a.y) - bf_lo(b.y); s[3] += bf_hi(a.y) - bf_hi(b.y);
            s[4] += bf_lo(a.z) - bf_lo(b.z); s[5] += bf_hi(a.z) - bf_hi(b.z); s[6] += bf_lo(a.w) - bf_lo(b.w); s[7] += bf_hi(a.w) - bf_hi(b.w); }
        const int n = (tin0 + t + 1 < WL) ? tin0 + t + 1 : WL; const float rn = 1.0f / (float)n; const u32x4 u0 = r[WL - 1 + t];
        u32x4 ov; ov.x = pk_bf16(s[0] * rn - bf_lo(u0.x), s[1] * rn - bf_hi(u0.x)); ov.y = pk_bf16(s[2] * rn - bf_lo(u0.y), s[3] * rn - bf_hi(u0.y));
        ov.z = pk_bf16(s[4] * rn - bf_lo(u0.z), s[5] * rn - bf_hi(u0.z)); ov.w = pk_bf16(s[6] * rn - bf_lo(u0.w), s[7] * rn - bf_hi(u0.w));
        *(u32x4*)(pg + (size_t)(tok0 + t) * 1024 + ch * 8) = ov; }
}

__global__ void __launch_bounds__(512, 2) mk_fwd(Args args) {
    extern __shared__ __attribute__((aligned(16))) unsigned char lds_raw[];
    LAS unsigned char* lds = (LAS unsigned char*)lds_raw;
    const int tid = threadIdx.x, lane = tid & 63, wid = __builtin_amdgcn_readfirstlane(tid >> 6), blk = blockIdx.x;
#define PHASE_IDS() int tid_o_ = threadIdx.x; asm volatile("" : "+v"(tid_o_)); const int tid = tid_o_, lane = tid & 63, wid = __builtin_amdgcn_readfirstlane(tid >> 6); (void)tid; (void)lane; (void)wid
    unsigned char* ws = args.ws;
    const float* x = args.in[0]; const float* cvec = args.in[1]; const float* w_mod = args.in[2]; const float* b_mod = args.in[3];
    const float* g_pre_mix = args.in[4]; const float* g_post_mix = args.in[5]; const float* w_in = args.in[6]; const float* b_in = args.in[7];
    const float* sinks = args.in[8]; const float* w_pool_mix = args.in[9]; const float* pool_scale = args.in[10];
    const float* w_attn_branch = args.in[11]; const float* w_pool_branch = args.in[12]; const float* w_out = args.in[13];
    const float* g_pre_ffn = args.in[14]; const float* g_post_ffn = args.in[15]; const float* w_router = args.in[16]; const float* b_router = args.in[17];
    const float* w_gate_up = args.in[18]; const float* b_gate_up = args.in[19]; const float* w_down = args.in[20]; const float* b_down = args.in[21];
    float* out = args.out;
    unsigned* ctl = (unsigned*)(ws + WS_CTL);
    unsigned* cntg = (unsigned*)(ws + WS_CTL + CTL_CNT_OFF);
    float* modv = (float*)(ws + WS_MOD);
    bf16_t* wrt = (bf16_t*)(ws + WS_WRT);
    bf16_t* hbuf = (bf16_t*)(ws + WS_H);
    bf16_t* proj = (bf16_t*)(ws + WS_PROJ);
    bf16_t* x1b = (bf16_t*)(ws + WS_PROJ);
    bf16_t* vt = (bf16_t*)(ws + WS_VT);
    bf16_t* att = (bf16_t*)(ws + WS_ATT);
    bf16_t* pg = (bf16_t*)(ws + WS_PG);
    bf16_t* wc = (bf16_t*)(ws + WS_PP);
    bf16_t* wms = (bf16_t*)(ws + WS_WMS);
    bf16_t* mrgf = (bf16_t*)(ws + WS_MRGF);
    bf16_t* mrg = (bf16_t*)(ws + WS_MRG);
    bf16_t* mix = (bf16_t*)(ws + WS_MIX);
    int* ltok = (int*)(ws + WS_LTOK);
    float* lw = (float*)(ws + WS_LW);
    int* tslot = (int*)(ws + WS_TSLOT);
    bf16_t* act = (bf16_t*)(ws + WS_ACT);
    bf16_t* yb = (bf16_t*)(ws + WS_YB);
    bf16_t* yb2 = (bf16_t*)(ws + WS_YB2);
    bf16_t* wbin = (bf16_t*)(ws + WS_WBIN); bf16_t* wba = (bf16_t*)(ws + WS_WBA); bf16_t* wbo = (bf16_t*)(ws + WS_WBO);
    unsigned char* sflag = (unsigned char*)(ws + WS_CTL + CTL_FLAG_OFF);

    if (tid < 4) ((LAS unsigned*)(lds + LDS_BAR))[tid] = 0u;
    __syncthreads();
    XcdBarrier bar; bar.bar = ctl; bar.x = 0; bar.st = nullptr;
    if (MK_N_LAUNCHES == 1) bar = xcd_barrier_post(ctl, (volatile LAS unsigned*)(lds + LDS_BAR));
    if (MK_N_LAUNCHES == 1 && tid == 0) { const unsigned xx = xb_xcc_id(); ((LAS unsigned*)(lds + LDS_BAR))[2] = xx; ((LAS unsigned*)(lds + LDS_BAR))[3] = xb_add((unsigned*)(ws + WS_CTL + CTL_RANK_OFF) + 64 * xx, 1u); }
    __syncthreads();
    const int lo = args.ph_lo, hi = args.ph_hi;
#ifndef PH_MASK
#define PH_MASK 0x7ff
#endif
#ifndef REP_MASK
#define REP_MASK 0
#endif
#define REPS(k) ((((REP_MASK) >> (k)) & 1) ? 2 : 1)
#define IN(k) ((((PH_MASK) >> (k)) & 1) && lo <= (k) && (k) < hi)
#define SEAM(k) do { if (IN(k) && IN((k) + 1)) xcd_barrier(bar); } while (0)

    int xcd = blk & 7, rnk = blk >> 3, nxcd = 8, npx = (int)gridDim.x >> 3;
#define XCD_SETUP() do { if (MK_N_LAUNCHES == 1) { const LAS unsigned* st_ = (const LAS unsigned*)(lds + LDS_BAR); \
        xcd = __builtin_amdgcn_readfirstlane((int)st_[2]); rnk = __builtin_amdgcn_readfirstlane((int)st_[3]); npx = __builtin_amdgcn_readfirstlane((int)st_[0]); nxcd = __builtin_amdgcn_readfirstlane((int)st_[1]); \
        if (npx < 1) npx = 1; if (nxcd < 1) nxcd = 1; } } while (0)

    if (IN(0)) for (int rep_ = 0; rep_ < REPS(0); ++rep_) { PHASE_IDS();
        LAS float* sc = (LAS float*)(lds + LDS_MAIN);
        LAS float* part = (LAS float*)(lds + LDS_MAIN + 16384);
        for (int i = tid; i < 4096; i += 512) { const float cv = cvec[i]; sc[i] = cv / (1.0f + __expf(-cv)); }
        __syncthreads();
        { const int j0 = 16 * blk;
          if (tid < 504) {
            const int q = tid & 3, kl = tid >> 2;
            f32x4 a0 = {0.f, 0.f, 0.f, 0.f}, a1 = {0.f, 0.f, 0.f, 0.f};
            const float* wp = w_mod + j0 + 4 * q;
#pragma unroll 4
            for (int k = kl; k < 2048; k += 126) { const f32x4 wv4 = *(const f32x4*)(wp + (size_t)k * 12288); a0 += wv4 * sc[k]; a1 += wv4 * sc[2048 + k]; }
#pragma unroll
            for (int e = 0; e < 4; ++e) { part[kl * 32 + q * 4 + e] = a0[e]; part[kl * 32 + 16 + q * 4 + e] = a1[e]; }
          }
          __syncthreads();
          if (tid < 32) { float s = 0.f; for (int kl = 0; kl < 126; ++kl) s += part[kl * 32 + tid]; const int b = tid >> 4, jj = tid & 15; modv[b * 12288 + j0 + jj] = s + b_mod[j0 + jj]; } }
        { const int gt = blk * 512 + tid;
          for (int i = gt; i < D * INW / 8; i += 131072) { const f32x4 a = *(const f32x4*)(w_in + (size_t)i * 8), b = *(const f32x4*)(w_in + (size_t)i * 8 + 4); u32x4 o; o.x = pk_bf16(a[0], a[1]); o.y = pk_bf16(a[2], a[3]); o.z = pk_bf16(b[0], b[1]); o.w = pk_bf16(b[2], b[3]); *(u32x4*)(wbin + (size_t)i * 8) = o; }
          for (int i = gt; i < 1024 * D / 8; i += 131072) { const f32x4 a = *(const f32x4*)(w_attn_branch + (size_t)i * 8), b = *(const f32x4*)(w_attn_branch + (size_t)i * 8 + 4); u32x4 o; o.x = pk_bf16(a[0], a[1]); o.y = pk_bf16(a[2], a[3]); o.z = pk_bf16(b[0], b[1]); o.w = pk_bf16(b[2], b[3]); *(u32x4*)(wba + (size_t)i * 8) = o; }
          for (int i = gt; i < D * D / 8; i += 131072) { const f32x4 a = *(const f32x4*)(w_out + (size_t)i * 8), b = *(const f32x4*)(w_out + (size_t)i * 8 + 4); u32x4 o; o.x = pk_bf16(a[0], a[1]); o.y = pk_bf16(a[2], a[3]); o.z = pk_bf16(b[0], b[1]); o.w = pk_bf16(b[2], b[3]); *(u32x4*)(wbo + (size_t)i * 8) = o; } }
        for (int i = blk * 512 + tid; i < 4 * 65536; i += 131072) { const int g = i >> 16, d = i & 255; wms[i] = (bf16_t)(pk_bf16(w_pool_mix[i] * pool_scale[g * 256 + d], 0.f) & 0xffffu); }
        { const int i = blk * 512 + tid; if (i < 65536) { const int e = i & 31, k = i >> 5; wrt[e * 2048 + k] = (bf16_t)(pk_bf16(w_router[i], 0.f) & 0xffffu); } }
        __syncthreads();
    }
    SEAM(0);
    if (MK_N_LAUNCHES == 1 && IN(0) && IN(1)) {
        if (threadIdx.x == 0) { LAS unsigned* st_ = (LAS unsigned*)(lds + LDS_BAR); const unsigned hx_ = st_[2]; unsigned ord_ = 0;
            for (unsigned j = 0; j < 16; ++j) { const unsigned c_ = ctl[XB_XCNT(j)]; if (j < hx_ && c_ > 0u) ++ord_; }
            st_[2] = ord_; }
        __syncthreads();
    }

    if (IN(1)) for (int rep_ = 0; rep_ < REPS(1); ++rep_) { PHASE_IDS();
        { const int rowb = blk * 32 + wid * 4; const int b = rowb >> 12;
          f32x4 cgs[8], csh[8];
#pragma unroll
          for (int j = 0; j < 8; ++j) { const int col = 4 * lane + 256 * j; cgs[j] = *(const f32x4*)(g_pre_mix + col) * (*(const f32x4*)(modv + b * 12288 + 2048 + col) + 1.0f); csh[j] = *(const f32x4*)(modv + b * 12288 + col); }
          f32x4 xw[2][8];
#pragma unroll
          for (int j = 0; j < 8; ++j) xw[0][j] = *(const f32x4*)(x + (size_t)rowb * D + 4 * lane + 256 * j);
#pragma unroll
          for (int rr = 0; rr < 4; ++rr) { const int sb = rr & 1; const int row = rowb + rr;
            if (rr < 3) {
#pragma unroll
                for (int j = 0; j < 8; ++j) xw[sb ^ 1][j] = *(const f32x4*)(x + (size_t)(row + 1) * D + 4 * lane + 256 * j); }
            float ss = 0.f;
#pragma unroll
            for (int j = 0; j < 8; ++j) { const f32x4 xv = xw[sb][j]; ss += xv[0] * xv[0] + xv[1] * xv[1] + xv[2] * xv[2] + xv[3] * xv[3]; }
            ss = wave_sum(ss); const float r = rsqrtf(ss * (1.0f / D) + RMS_EPS);
#pragma unroll
            for (int j = 0; j < 8; ++j) { const int col = 4 * lane + 256 * j;
                const f32x4 h = xw[sb][j] * r * cgs[j] + csh[j];
                u32x2 o; o.x = pk_bf16(h[0], h[1]); o.y = pk_bf16(h[2], h[3]); *(u32x2*)(hbuf + (size_t)row * HS + col) = o; }
          } }
    }
    SEAM(1);

    if (IN(2)) for (int rep_ = 0; rep_ < REPS(2); ++rep_) { PHASE_IDS();
        XCD_SETUP();
        const int U = 32 * 26; const int ulo = (U * xcd) / nxcd, uhi = (U * (xcd + 1)) / nxcd;
        { int cnt3 = 0; for (int k = 0; k < 3; ++k) if (ulo + rnk + k * npx < uhi) ++cnt3;
          SchedProj S{hbuf, wbin, proj, vt, b_in, ulo + rnk, npx, cnt3}; gemm_stream<SchedProj, false, true>(lds, S); }
    }
    SEAM(2);

    if (IN(3)) for (int rep_ = 0; rep_ < REPS(3); ++rep_) { PHASE_IDS();
        XCD_SETUP();
        int nleft, wk, nwk;
        { const int U = 32 * 26; const int ulo = (U * xcd) / nxcd, uhi = (U * (xcd + 1)) / nxcd; nleft = uhi - ulo - 3 * npx; if (nleft < 0) nleft = 0; if (nleft > npx - 1) nleft = npx - 1;
          if (rnk < nleft) { int c = 0; for (int u = ulo + 3 * npx + rnk; u < uhi; u += nleft) ++c; SchedProj S{hbuf, wbin, proj, vt, b_in, ulo + 3 * npx + rnk, nleft, c}; gemm_stream<SchedProj, false, true>(lds, S); }
          wk = rnk - nleft; nwk = npx - nleft; }
        const int alo = (256 * xcd) / nxcd, ahi = (256 * (xcd + 1)) / nxcd;
        if (wk >= 0) for (int u = alo + wk; u < ahi; u += nwk) {
            const int b = u >> 7, nb = (u >> 2) & 31, kvh = u & 3;
            const int tok0 = b * SEQ + nb * 128;
            LAS unsigned char* Kl = lds + LDS_MAIN;
            LAS unsigned char* Vl = lds + LDS_MAIN + 32768;
            __syncthreads();
#pragma unroll
            for (int p = 0; p < 4; ++p) { const int q = tid + 512 * p; const int row = q >> 3, ch = q & 7; const bool ok = (nb > 0) || (row >= 128);
                u32x4 v = {0u, 0u, 0u, 0u};
                if (ok) v = *(const u32x4*)(proj + (size_t)(tok0 - 128 + row) * INW + 1024 + kvh * 64 + ch * 8);
                *(LAS u32x4*)(Kl + row * 128 + ((ch ^ swz(row)) << 4)) = v; }
#pragma unroll
            for (int p = 0; p < 4; ++p) { const int q = tid + 512 * p; const int d = q >> 5, ch = q & 31; const bool ok = (nb > 0) || (ch >= 16);
                u32x4 v = {0u, 0u, 0u, 0u};
                if (ok) v = *(const u32x4*)(vt + ((size_t)((b * 4 + kvh) * 64 + d)) * SEQ + (nb * 128 - 128 + ch * 8));
                *(LAS u32x4*)(Vl + d * 528 + ch * 16) = v; }
            __syncthreads();
            const int g = wid >> 1, half = wid & 1, hq = kvh * 4 + g;
            const float sink2 = sinks[hq] * LOG2E;
            const int lr = lane & 15, lq = lane >> 4;
#pragma unroll 1
            for (int a4 = 0; a4 < 4; ++a4) {
                const int a = half * 4 + a4; const int qrow = tok0 + 16 * a + lr; const int p0 = a >> 1;
                bf16x8 qf[2];
#pragma unroll
                for (int ks = 0; ks < 2; ++ks) qf[ks] = *(const bf16x8*)(proj + (size_t)qrow * INW + hq * 64 + ks * 32 + lq * 8);
                f32x4 s[10];
#pragma unroll
                for (int ff = 0; ff < 10; ++ff) { const int krow = 16 * (2 * p0 + ff) + lr; const int sw = swz(krow);
                    const bf16x8 k0 = *(const LAS bf16x8*)(Kl + krow * 128 + (((0 + lq) ^ sw) << 4));
                    const bf16x8 k1 = *(const LAS bf16x8*)(Kl + krow * 128 + (((4 + lq) ^ sw) << 4));
                    f32x4 z = {0.f, 0.f, 0.f, 0.f};
                    z = __builtin_amdgcn_mfma_f32_16x16x32_bf16(k0, qf[0], z, 0, 0, 0);
                    s[ff] = __builtin_amdgcn_mfma_f32_16x16x32_bf16(k1, qf[1], z, 0, 0, 0); }
                const int iq = 16 * a + lr; float m = sink2;
#pragma unroll
                for (int ff = 0; ff < 10; ++ff)
#pragma unroll
                    for (int e = 0; e < 4; ++e) { const int kp = 16 * (2 * p0 + ff) + 4 * lq + e; const bool ok = (kp > iq) && (kp <= iq + 128) && ((nb > 0) || (kp >= 128));
                        s[ff][e] = ok ? s[ff][e] : -1e30f; m = fmaxf(m, s[ff][e]); }
                m = fmaxf(m, __shfl_xor(m, 16)); m = fmaxf(m, __shfl_xor(m, 32));
                float sum = 0.f;
#pragma unroll
                for (int ff = 0; ff < 10; ++ff)
#pragma unroll
                    for (int e = 0; e < 4; ++e) { const float pv = exp2f(s[ff][e] - m); s[ff][e] = pv; sum += pv; }
                sum += __shfl_xor(sum, 16); sum += __shfl_xor(sum, 32);
                sum += exp2f(sink2 - m);
                const float inv = 1.0f / sum;
                f32x4 o[4];
#pragma unroll
                for (int df = 0; df < 4; ++df) o[df] = (f32x4){0.f, 0.f, 0.f, 0.f};
#pragma unroll
                for (int pr = 0; pr < 5; ++pr) {
                    u32x4 pw; pw.x = pk_bf16(s[2 * pr][0], s[2 * pr][1]); pw.y = pk_bf16(s[2 * pr][2], s[2 * pr][3]); pw.z = pk_bf16(s[2 * pr + 1][0], s[2 * pr + 1][1]); pw.w = pk_bf16(s[2 * pr + 1][2], s[2 * pr + 1][3]);
                    const bf16x8 pf = __builtin_bit_cast(bf16x8, pw);
                    const int key0 = 16 * (2 * p0 + 2 * pr) + 4 * lq;
#pragma unroll
                    for (int df = 0; df < 4; ++df) { const LAS unsigned char* vp = Vl + (16 * df + lr) * 528 + key0 * 2;
                        const u32x2 v0 = *(const LAS u32x2*)vp, v1 = *(const LAS u32x2*)(vp + 32);
                        u32x4 vw; vw.x = v0.x; vw.y = v0.y; vw.z = v1.x; vw.w = v1.y;
                        o[df] = __builtin_amdgcn_mfma_f32_16x16x32_bf16(__builtin_bit_cast(bf16x8, vw), pf, o[df], 0, 0, 0); }
                }
#pragma unroll
                for (int df = 0; df < 4; ++df) { u32x2 ov; ov.x = pk_bf16(o[df][0] * inv, o[df][1] * inv); ov.y = pk_bf16(o[df][2] * inv, o[df][3] * inv);
                    *(u32x2*)(att + (size_t)qrow * 1024 + hq * 64 + 16 * df + 4 * lq) = ov; }
            }
        }
        if (wk >= 0) {
            const int tlo = (T * xcd) / nxcd, thi = (T * (xcd + 1)) / nxcd;
            if (((thi - tlo) & 15) == 0) {
                const int nit = (thi - tlo) / 4;
#pragma unroll 1
                for (int it = wk * 8 + wid; it < nit; it += nwk * 8) { const int gi = it & 3, tok0 = tlo + ((it >> 2) * 2 + (lane >> 5)) * 8, ch = gi * 32 + (lane & 31);
                    if (gi == 0) pool_run<2>(proj, pg, tok0, ch); else if (gi == 1) pool_run<4>(proj, pg, tok0, ch); else if (gi == 2) pool_run<8>(proj, pg, tok0, ch); else pool_run<16>(proj, pg, tok0, ch); }
            } else {
            const int nitem = (thi - tlo) * 2;
#pragma unroll 1
            for (int it = wk * 8 + wid; it < nitem; it += nwk * 8) {
                const int gi = it & 3, tok = tlo + (it >> 2) * 2 + (lane >> 5), ch = gi * 32 + (lane & 31); const int tin = tok & (SEQ - 1);
                const int wl = 2 << gi; const int n = (tin + 1 < wl) ? tin + 1 : wl;
                float sacc[8];
#pragma unroll
                for (int e = 0; e < 8; ++e) sacc[e] = 0.f;
                const bf16_t* up = proj + (size_t)tok * INW + 1536 + ch * 8;
                const u32x4 u0 = *(const u32x4*)up;
                { u32x4 uv[16];
#pragma unroll
                    for (int k = 0; k < 16; ++k) { uv[k] = (u32x4){0u, 0u, 0u, 0u}; if (k < n) uv[k] = *(const u32x4*)(up - (size_t)k * INW); }
#pragma unroll
                    for (int k = 0; k < 16; ++k) { sacc[0] += bf_lo(uv[k].x); sacc[1] += bf_hi(uv[k].x); sacc[2] += bf_lo(uv[k].y); sacc[3] += bf_hi(uv[k].y); sacc[4] += bf_lo(uv[k].z); sacc[5] += bf_hi(uv[k].z); sacc[6] += bf_lo(uv[k].w); sacc[7] += bf_hi(uv[k].w); } }
                const float rn = 1.0f / (float)n;
                u32x4 ov; ov.x = pk_bf16(sacc[0] * rn - bf_lo(u0.x), sacc[1] * rn - bf_hi(u0.x)); ov.y = pk_bf16(sacc[2] * rn - bf_lo(u0.y), sacc[3] * rn - bf_hi(u0.y));
                ov.z = pk_bf16(sacc[4] * rn - bf_lo(u0.z), sacc[5] * rn - bf_hi(u0.z)); ov.w = pk_bf16(sacc[6] * rn - bf_lo(u0.w), sacc[7] * rn - bf_hi(u0.w));
                *(u32x4*)(pg + (size_t)tok * 1024 + ch * 8) = ov;
            } }
        }
        if (wk >= 0) {
            LAS int* tk = (LAS int*)(lds + LDS_TAB);
            for (;;) {
                __syncthreads();
                if (tid == 0) tk[0] = (int)atomicAdd(ctl + CTL_TICKET_OFF / 4 + 64, 1u);
                __syncthreads();
                const int tkt = __builtin_amdgcn_readfirstlane(tk[0]);
                if (tkt >= 32) break;
                { SchedWc S{wms, w_pool_branch, wc, tkt >> 3, (tkt & 7) * 256}; gemm_stream(lds, S); }
            }
        }
        if (wk >= 0) {
            LAS float* sc = (LAS float*)(lds + LDS_MAIN);
            LAS float* part = (LAS float*)(lds + LDS_MAIN + 16384);
            LAS int* tk = (LAS int*)(lds + LDS_TAB);
            __syncthreads();
            for (int i = tid; i < 4096; i += 512) { const float cv = cvec[i]; sc[i] = cv / (1.0f + __expf(-cv)); }
            for (;;) {
                __syncthreads();
                if (tid == 0) tk[0] = (int)atomicAdd(ctl + CTL_TICKET_OFF / 4, 1u);
                __syncthreads();
                const int cb = __builtin_amdgcn_readfirstlane(tk[0]);
                if (cb >= 171) break;
                const int j0 = 4096 + 48 * cb; const int ncol = (j0 + 48 <= 12288) ? 48 : 12288 - j0;
                if (tid < 504) {
                    const int q = tid % 12, kl = tid / 12;
                    f32x4 a0 = {0.f, 0.f, 0.f, 0.f}, a1 = {0.f, 0.f, 0.f, 0.f};
                    if (4 * q < ncol) { const float* wp = w_mod + j0 + 4 * q;
#pragma unroll 7
                        for (int k = kl; k < 2048; k += 42) { const f32x4 wv4 = *(const f32x4*)(wp + (size_t)k * 12288); a0 += wv4 * sc[k]; a1 += wv4 * sc[2048 + k]; } }
#pragma unroll
                    for (int e = 0; e < 4; ++e) { part[kl * 96 + q * 4 + e] = a0[e]; part[kl * 96 + 48 + q * 4 + e] = a1[e]; }
                }
                __syncthreads();
                if (tid < 96) { float s2 = 0.f; for (int kl = 0; kl < 42; ++kl) s2 += part[kl * 96 + tid]; const int b = tid / 48, jj = tid % 48; if (jj < ncol) modv[b * 12288 + j0 + jj] = s2 + b_mod[j0 + jj]; }
            }
        }
        __syncthreads();
    }
    SEAM(3);


    if (IN(5)) for (int rep_ = 0; rep_ < REPS(5); ++rep_) { PHASE_IDS();
        XCD_SETUP();
        const int ulo = (256 * xcd) / nxcd, uhi = (256 * (xcd + 1)) / nxcd;
        { int c = 0; for (int u = ulo + rnk; u < uhi; u += npx) ++c;
          SchedBranch S{att, pg, wba, wc, mrgf, mrg, proj, ulo + rnk, npx, c}; gemm_stream<SchedBranch, false, true>(lds, S); }
    }
    SEAM(5);

    if (IN(6)) for (int rep_ = 0; rep_ < REPS(6); ++rep_) { PHASE_IDS();
        XCD_SETUP();
        const int ulo = (256 * xcd) / nxcd, uhi = (256 * (xcd + 1)) / nxcd;
        { int c = 0; for (int u = ulo + rnk; u < uhi; u += npx) ++c;
          SchedOut S{mrg, wbo, mix, ulo + rnk, npx, c}; gemm_stream<SchedOut, false, true>(lds, S); }
    }
    SEAM(6);

    if (IN(7)) { PHASE_IDS();
        LAS unsigned char* h2s = lds + LDS_MAIN;
        LAS float* part = (LAS float*)(lds + LDS_MAIN);
        LAS float* lgt = (LAS float*)(lds + LDS_MAIN + 32768);
        LAS int* lcnt = (LAS int*)(lds + LDS_TAB);
        LAS int* sel = (LAS int*)(lds + LDS_TAB + 256);
        LAS float* selw = (LAS float*)(lds + LDS_TAB + 256 + 1024);
        for (int tile = blk; tile < T / 32; tile += gridDim.x) {
            __syncthreads();
            if (tid < 64) lcnt[tid] = 0;
            f32x4 cga[8], cgs[8];
            const float* mb = modv + ((tile * 32) >> 12) * 12288;
            const __amdgpu_buffer_rsrc_t r_gpm = mk_rsrc(g_post_mix, 8192u), r_gpf = mk_rsrc(g_pre_ffn, 8192u), r_mod = mk_rsrc(mb, 12288u * 4u);
            const unsigned lo16 = (unsigned)(lane * 16);
#pragma unroll
            for (int j = 0; j < 8; ++j) {
                cga[j] = __builtin_bit_cast(f32x4, __builtin_amdgcn_raw_buffer_load_b128(r_gpm, lo16, 1024 * j, 0)) * __builtin_bit_cast(f32x4, __builtin_amdgcn_raw_buffer_load_b128(r_mod, lo16, 2 * 8192 + 1024 * j, 0));
                cgs[j] = __builtin_bit_cast(f32x4, __builtin_amdgcn_raw_buffer_load_b128(r_gpf, lo16, 1024 * j, 0)) * (__builtin_bit_cast(f32x4, __builtin_amdgcn_raw_buffer_load_b128(r_mod, lo16, 4 * 8192 + 1024 * j, 0)) + 1.0f); }
#pragma unroll 1
            for (int rr = 0; rr < 4; ++rr) {
                const int rl = wid * 4 + rr; const int row = tile * 32 + rl;
                f32x4 mv[8], xw[8]; float ss = 0.f;
                u32x2 mw[8];
#pragma unroll
                for (int j = 0; j < 8; ++j) { mw[j] = *(const u32x2*)(mix + (size_t)row * D + 4 * lane + 256 * j); xw[j] = *(const f32x4*)(x + (size_t)row * D + 4 * lane + 256 * j); }
#pragma unroll
                for (int j = 0; j < 8; ++j) { mv[j] = (f32x4){bf_lo(mw[j].x), bf_hi(mw[j].x), bf_lo(mw[j].y), bf_hi(mw[j].y)}; ss += mv[j][0] * mv[j][0] + mv[j][1] * mv[j][1] + mv[j][2] * mv[j][2] + mv[j][3] * mv[j][3]; }
                ss = wave_sum(ss); const float r1 = rsqrtf(ss * (1.0f / D) + RMS_EPS);
                float ss2 = 0.f;
#pragma unroll
                for (int j = 0; j < 8; ++j) { const int col = 4 * lane + 256 * j;
                    const f32x4 x1 = xw[j] + cga[j] * (mv[j] * r1);
                    { u32x2 xo; xo.x = pk_bf16(x1[0], x1[1]); xo.y = pk_bf16(x1[2], x1[3]); *(u32x2*)(x1b + (size_t)row * D + col) = xo; } mv[j] = x1;
                    ss2 += x1[0] * x1[0] + x1[1] * x1[1] + x1[2] * x1[2] + x1[3] * x1[3]; }
                ss2 = wave_sum(ss2); const float r2 = rsqrtf(ss2 * (1.0f / D) + RMS_EPS);
#pragma unroll
                for (int j = 0; j < 8; ++j) { const int col = 4 * lane + 256 * j;
                    const f32x4 h = mv[j] * r2 * cgs[j] + __builtin_bit_cast(f32x4, __builtin_amdgcn_raw_buffer_load_b128(r_mod, lo16, 3 * 8192 + 1024 * j, 0));
                    u32x2 o; o.x = pk_bf16(h[0], h[1]); o.y = pk_bf16(h[2], h[3]);
                    *(u32x2*)(hbuf + (size_t)row * HS + col) = o; *(LAS u32x2*)(h2s + rl * 4112 + col * 2) = o; }
            }
            __syncthreads();
            f32x4 lacc[2][2];
#pragma unroll
            for (int mi = 0; mi < 2; ++mi)
#pragma unroll
                for (int ni = 0; ni < 2; ++ni) lacc[mi][ni] = (f32x4){0.f, 0.f, 0.f, 0.f};
#pragma unroll
            for (int ks = 0; ks < 8; ++ks) { const int k0 = 256 * wid + 32 * ks + 8 * (lane >> 4);
                bf16x8 af[2], bfv[2];
#pragma unroll
                for (int mi = 0; mi < 2; ++mi) af[mi] = *(const LAS bf16x8*)(h2s + (16 * mi + (lane & 15)) * 4112 + k0 * 2);
#pragma unroll
                for (int ni = 0; ni < 2; ++ni) bfv[ni] = *(const bf16x8*)(wrt + (16 * ni + (lane & 15)) * 2048 + k0);
#pragma unroll
                for (int mi = 0; mi < 2; ++mi)
#pragma unroll
                    for (int ni = 0; ni < 2; ++ni) lacc[mi][ni] = __builtin_amdgcn_mfma_f32_16x16x32_bf16(af[mi], bfv[ni], lacc[mi][ni], 0, 0, 0); }
            __syncthreads();
#pragma unroll
            for (int mi = 0; mi < 2; ++mi)
#pragma unroll
                for (int ni = 0; ni < 2; ++ni)
#pragma unroll
                    for (int e = 0; e < 4; ++e) part[(wid * 32 + 16 * mi + 4 * (lane >> 4) + e) * 32 + 16 * ni + (lane & 15)] = lacc[mi][ni][e];
            __syncthreads();
            for (int o = tid; o < 1024; o += 512) { const int r = o >> 5, e = o & 31; float s = b_router[e];
#pragma unroll
                for (int ww = 0; ww < 8; ++ww) s += part[(ww * 32 + r) * 32 + e];
                lgt[r * 33 + e] = s; }
            __syncthreads();
            if (tid < 32) {
                const int r = tid; float vals[4]; int idx[4]; unsigned used = 0u;
#pragma unroll
                for (int k = 0; k < 4; ++k) { float best = -3.0e38f; int bi = 0;
                    for (int e = 0; e < 32; ++e) { const float v = lgt[r * 33 + e]; if (!((used >> e) & 1u) && v > best) { best = v; bi = e; } }
                    used |= 1u << bi; vals[k] = best; idx[k] = bi; }
                float ex[4], se = 0.f;
#pragma unroll
                for (int k = 0; k < 4; ++k) { ex[k] = __expf(vals[k] - vals[0]); se += ex[k]; }
#pragma unroll
                for (int k = 0; k < 4; ++k) { sel[r * 4 + k] = idx[k]; sel[128 + r * 4 + k] = atomicAdd((int*)&lcnt[idx[k]], 1); selw[r * 4 + k] = ex[k] / se; }
            }
            __syncthreads();
            if (tid < 32) { const int c = lcnt[tid]; lcnt[32 + tid] = c ? (int)atomicAdd(&cntg[16 * tid], (unsigned)c) : 0; }
            __syncthreads();
            if (tid < 128) { const int r = tid >> 2; const int e = sel[tid]; const int pos = lcnt[32 + e] + sel[128 + tid]; const int tok = tile * 32 + r;
                ltok[e * T + pos] = tok; lw[e * T + pos] = selw[tid]; tslot[tok * 4 + (tid & 3)] = (e << 16) | pos; }
        }
        __syncthreads();
    }
    SEAM(7);

    if (IN(8)) for (int rep_ = 0; rep_ < REPS(8); ++rep_) { PHASE_IDS();
        moe_tables(lds, cntg);
        const LAS int* tab = (const LAS int*)(lds + LDS_TAB);
        XCD_SETUP();
        const int U = __builtin_amdgcn_readfirstlane(tab[96]) * 16; const int ulo = (U * xcd) / nxcd, uhi = (U * (xcd + 1)) / nxcd;
        { SchedGateUp S{lds, hbuf, ltok, w_gate_up, b_gate_up, act, ulo + rnk, npx, uhi}; gemm_stream<SchedGateUp, true>(lds, S); }
    }
    SEAM(8);

    if (IN(9)) for (int rep_ = 0; rep_ < REPS(9); ++rep_) { PHASE_IDS();
        moe_tables(lds, cntg);
        const LAS int* tab = (const LAS int*)(lds + LDS_TAB);
        XCD_SETUP();
        const int U = __builtin_amdgcn_readfirstlane(tab[96]) * 8; const int ulo = (U * xcd) / nxcd, uhi = (U * (xcd + 1)) / nxcd;
        const int chunk = uhi - ulo, full = chunk / npx, rem = chunk - full * npx; const bool split = (rem > 0) && (2 * rem <= npx);
        { int last = -1, lastkh = -1;
          if (rem > 0) { if (split) { if (rnk < 2 * rem) { last = ulo + full * npx + (rnk >> 1); lastkh = rnk & 1; } } else if (rnk < rem) last = ulo + full * npx + rnk; }
          SchedDown S{lds, act, lw, w_down, b_down, yb, yb2, sflag, ulo + rnk, npx, full, last, lastkh}; gemm_stream<SchedDown, true>(lds, S); }
    }
    SEAM(9);

    if (IN(10)) { PHASE_IDS();
        moe_tables(lds, cntg);
        const LAS int* tab = (const LAS int*)(lds + LDS_TAB);
        const int row0 = blk * 32 + wid * 4; const int b = row0 >> 12;
        f32x4 gg[8];
#pragma unroll
        for (int q = 0; q < 8; ++q) { const int col = 8 * lane + 512 * (q >> 1) + 4 * (q & 1); gg[q] = *(const f32x4*)(g_post_ffn + col) * *(const f32x4*)(modv + b * 12288 + 5 * 2048 + col); }
        int prow[4][4]; unsigned long long fl[4][4];
#pragma unroll
        for (int rr = 0; rr < 4; ++rr) { const i32x4 ts = *(const i32x4*)(tslot + (size_t)(row0 + rr) * 4);
#pragma unroll
            for (int k = 0; k < 4; ++k) prow[rr][k] = tab[64 + (ts[k] >> 16)] * 256 + (ts[k] & 0xffff); }
#pragma unroll
        for (int rr = 0; rr < 4; ++rr)
#pragma unroll
            for (int k = 0; k < 4; ++k) fl[rr][k] = *(const unsigned long long*)(sflag + (size_t)(prow[rr][k] >> 8) * 8);
        const __amdgpu_buffer_rsrc_t y2rs = mk_rsrc(yb2, (unsigned)((size_t)NPADROWS * D * 2));
#pragma unroll
        for (int rr = 0; rr < 4; ++rr) { const int row = row0 + rr;
            u32x4 x1w[4];
#pragma unroll
            for (int j = 0; j < 4; ++j) x1w[j] = *(const u32x4*)(x1b + (size_t)row * D + 8 * lane + 512 * j);
            float yv[4][8]; float ss = 0.f;
#pragma unroll
            for (int j = 0; j < 4; ++j) { const int col = 8 * lane + 512 * j; const int pnb = 8 * (2 * j + (lane >> 5));
                u32x4 v[4], v2[4];
#pragma unroll
                for (int k = 0; k < 4; ++k) { v[k] = *(const u32x4*)(yb + (size_t)prow[rr][k] * D + col);
                    const unsigned off2 = ((fl[rr][k] >> pnb) & 1ull) ? (unsigned)((prow[rr][k] * D + col) * 2) : 0xfffffff0u;
                    v2[k] = __builtin_bit_cast(u32x4, __builtin_amdgcn_raw_buffer_load_b128(y2rs, off2, 0, 0)); }
#pragma unroll
                for (int e = 0; e < 8; ++e) yv[j][e] = 0.f;
#pragma unroll
                for (int k = 0; k < 4; ++k) { yv[j][0] += bf_lo(v2[k].x); yv[j][1] += bf_hi(v2[k].x); yv[j][2] += bf_lo(v2[k].y); yv[j][3] += bf_hi(v2[k].y); yv[j][4] += bf_lo(v2[k].z); yv[j][5] += bf_hi(v2[k].z); yv[j][6] += bf_lo(v2[k].w); yv[j][7] += bf_hi(v2[k].w); }
#pragma unroll
                for (int k = 0; k < 4; ++k) { yv[j][0] += bf_lo(v[k].x); yv[j][1] += bf_hi(v[k].x); yv[j][2] += bf_lo(v[k].y); yv[j][3] += bf_hi(v[k].y); yv[j][4] += bf_lo(v[k].z); yv[j][5] += bf_hi(v[k].z); yv[j][6] += bf_lo(v[k].w); yv[j][7] += bf_hi(v[k].w); }
#pragma unroll
                for (int e = 0; e < 8; ++e) ss += yv[j][e] * yv[j][e]; }
            ss = wave_sum(ss); const float r = rsqrtf(ss * (1.0f / D) + RMS_EPS);
#pragma unroll
            for (int q = 0; q < 8; ++q) { const int col = 8 * lane + 512 * (q >> 1) + 4 * (q & 1);
                const f32x4 y = {yv[q >> 1][4 * (q & 1)], yv[q >> 1][4 * (q & 1) + 1], yv[q >> 1][4 * (q & 1) + 2], yv[q >> 1][4 * (q & 1) + 3]};
                const u32x4 xw_ = x1w[q >> 1]; const f32x4 x1 = (q & 1) ? (f32x4){bf_lo(xw_.z), bf_hi(xw_.z), bf_lo(xw_.w), bf_hi(xw_.w)} : (f32x4){bf_lo(xw_.x), bf_hi(xw_.x), bf_lo(xw_.y), bf_hi(xw_.y)};
                *(f32x4*)(out + (size_t)row * D + col) = x1 + gg[q] * (y * r); }
        }
    }

#undef IN
#undef SEAM
}

extern "C" void kernel_launch(void* const* d_in, const int* in_sizes, int n_in, void* d_out, int out_size, void* d_ws, size_t ws_size, hipStream_t stream) {
    static int grid = 0;
    if (grid == 0) {
        if (n_in != 22 || out_size != T * D || ws_size < WS_END) { fprintf(stderr, "kernel_launch: unexpected shapes (n_in %d out %d ws %zu need %zu)\n", n_in, out_size, ws_size, (size_t)WS_END); grid = -1; return; }
        int dev = 0, cus = 0, per_cu = 0;
        if (hipGetDevice(&dev) != hipSuccess || hipDeviceGetAttribute(&cus, hipDeviceAttributeMultiprocessorCount, dev) != hipSuccess) { grid = -1; return; }
        if (hipFuncSetAttribute((const void*)mk_fwd, hipFuncAttributeMaxDynamicSharedMemorySize, LDS_BYTES) != hipSuccess) { fprintf(stderr, "kernel_launch: hipFuncSetAttribute failed\n"); grid = -1; return; }
        if (hipOccupancyMaxActiveBlocksPerMultiprocessor(&per_cu, (const void*)mk_fwd, 512, LDS_BYTES) != hipSuccess || per_cu < 1) fprintf(stderr, "kernel_launch: occupancy query says %d\n", per_cu);
        (void)hipGetLastError();
        grid = cus;
    }
    if (grid < 0) return;
    (void)hipMemsetAsync((char*)d_ws + WS_CTL, 0, CTL_BYTES, stream);
    Args a{};
    for (int i = 0; i < 22; ++i) a.in[i] = (const float*)d_in[i];
    a.out = (float*)d_out; a.ws = (unsigned char*)d_ws;
    if (MK_N_LAUNCHES == 1) {
        a.ph_lo = 0; a.ph_hi = NPHASE;
        hipLaunchKernelGGL(mk_fwd, dim3(grid), dim3(512), LDS_BYTES, stream, a);
    } else {
        for (int p = 0; p < NPHASE; ++p) { a.ph_lo = p; a.ph_hi = p + 1; hipLaunchKernelGGL(mk_fwd, dim3(grid), dim3(512), LDS_BYTES, stream, a); }
    }
    const hipError_t le = hipPeekAtLastError();
    if (le != hipSuccess) fprintf(stderr, "kernel_launch: launch failed: %s\n", hipGetErrorName(le));
}
```

```cpp
#include <hip/hip_runtime.h>
#include <hip/hip_bf16.h>
#include <cstdio>
#include <cstdint>

#ifndef MK_N_LAUNCHES
#define MK_N_LAUNCHES 1
#endif

constexpr int T = 8192, D = 2048, SEQ = 4096, INW = 6656, NE = 32, DFF = 2048;
constexpr int NPHASE = 11;
constexpr int HS = 2048 + 64;
constexpr float RMS_EPS = 1e-6f;
constexpr float LOG2E = 1.4426950408889634f;

#define LAS __attribute__((address_space(3)))
typedef unsigned short bf16_t;
typedef short bf16x8 __attribute__((ext_vector_type(8)));
typedef float f32x4 __attribute__((ext_vector_type(4)));
typedef float f32x2 __attribute__((ext_vector_type(2)));
typedef unsigned u32x4 __attribute__((ext_vector_type(4)));
typedef unsigned u32x2 __attribute__((ext_vector_type(2)));
typedef __bf16 bf16x2_t __attribute__((ext_vector_type(2)));

#define XB_TMO      128
#define XB_XCNT(j)  (256  + 64 * (j))
#define XB_XSUB(j)  (1280 + 64 * (j))
#define XB_XGEN(j)  (2304 + 64 * (j))
#define XB_TOP      3328
#define XB_TOPGEN   3392
#define XCD_BAR_WORDS 3456
#define XB_SPIN_CAP (1u << 18)

__device__ __forceinline__ unsigned xb_ld(unsigned* p)              { return __hip_atomic_load(p, __ATOMIC_RELAXED, __HIP_MEMORY_SCOPE_AGENT); }
__device__ __forceinline__ unsigned xb_add(unsigned* p, unsigned v) { return __hip_atomic_fetch_add(p, v, __ATOMIC_RELAXED, __HIP_MEMORY_SCOPE_AGENT); }
__device__ __forceinline__ unsigned xb_xcc_id() { return (unsigned)__builtin_amdgcn_s_getreg((3 << 11) | 20) & 0xFu; }
#define XB_SPIN(cond, bar) do { unsigned _sp = 0; while (cond) { __builtin_amdgcn_s_sleep(1); \
    if ((++_sp & 255u) == 0u) { if (xb_ld(&(bar)[XB_TMO])) break; if (_sp > XB_SPIN_CAP) { atomicAdd(&(bar)[XB_TMO], 1u); break; } } } } while (0)

struct XcdBarrier { unsigned* bar; unsigned x; volatile LAS unsigned* st; };

__device__ __forceinline__ XcdBarrier xcd_barrier_post(unsigned* bar, volatile LAS unsigned* st) {
    XcdBarrier b; b.bar = bar; b.x = xb_xcc_id(); b.st = st;
    if (threadIdx.x == 0) (void)xb_add(&bar[XB_XCNT(b.x)], 1u);
    return b;
}
__device__ __forceinline__ void xcd_barrier_complete(unsigned* bar, unsigned x, unsigned& nloc, unsigned& nx) {
    const unsigned G = gridDim.x * gridDim.y * gridDim.z;
    unsigned sum, cnt, mine, sp = 0u;
    for (;;) {
        sum = 0u; cnt = 0u; mine = 0u;
#pragma unroll
        for (unsigned j = 0; j < 16; ++j) { const unsigned c = xb_ld(&bar[XB_XCNT(j)]); sum += c; cnt += (c > 0u) ? 1u : 0u; mine = (j == x) ? c : mine; }
        if (sum == G) break;
        __builtin_amdgcn_s_sleep(1);
        if ((++sp & 255u) == 0u) { if (xb_ld(&bar[XB_TMO])) break; if (sp > XB_SPIN_CAP) { atomicAdd(&bar[XB_TMO], 1u); break; } }
    }
    nloc = mine > 0u ? mine : 1u; nx = cnt > 0u ? cnt : 1u;
}
__device__ __forceinline__ void xcd_barrier(const XcdBarrier& b) {
    asm volatile("s_waitcnt vmcnt(0)" ::: "memory");
    __syncthreads();
    if (threadIdx.x == 0) {
        unsigned* bar = b.bar;
        __builtin_amdgcn_s_waitcnt(0);
        unsigned nloc = b.st[0], nx = b.st[1];
        if (nloc == 0u) { xcd_barrier_complete(bar, b.x, nloc, nx); b.st[0] = nloc; b.st[1] = nx; }
        const unsigned old = xb_add(&bar[XB_XSUB(b.x)], 1u);
        const unsigned gen = old / nloc;
        if (old + 1u == (gen + 1u) * nloc) {
            __builtin_amdgcn_fence(__ATOMIC_RELEASE, "agent");
            asm volatile("s_waitcnt vmcnt(0)" ::: "memory");
            const unsigned og = xb_add(&bar[XB_TOP], 1u);
            const unsigned tg = og / nx;
            if (og + 1u == (tg + 1u) * nx) xb_add(&bar[XB_TOPGEN], 1u);
            else XB_SPIN(xb_ld(&bar[XB_TOPGEN]) == tg, bar);
            __builtin_amdgcn_fence(__ATOMIC_ACQUIRE, "agent");
            xb_add(&bar[XB_XGEN(b.x)], 1u);
            asm volatile("s_waitcnt vmcnt(0)" ::: "memory");
        } else {
            XB_SPIN(xb_ld(&bar[XB_XGEN(b.x)]) == gen, bar);
            __builtin_amdgcn_fence(__ATOMIC_ACQUIRE, "agent");
            asm volatile("s_waitcnt vmcnt(0)" ::: "memory");
        }
    }
    __syncthreads();
}

constexpr size_t al256(size_t x) { return (x + 255) & ~(size_t)255; }
constexpr size_t WS_CTL   = 0;
constexpr size_t CTL_BYTES = 65536;
constexpr size_t CTL_CNT_OFF = 16384;
constexpr size_t CTL_RANK_OFF = 32768;
constexpr size_t CTL_TICKET_OFF = 49152;
constexpr size_t CTL_FLAG_OFF = 53248;
constexpr size_t WS_MOD   = WS_CTL + CTL_BYTES;
constexpr size_t WS_WRT   = al256(WS_MOD + 2 * 12288 * 4);
constexpr size_t WS_WMS   = al256(WS_WRT + 32 * 2048 * 2);
constexpr size_t WS_H     = al256(WS_WMS + 4 * 256 * 256 * 2);
constexpr size_t WS_PROJ  = al256(WS_H + (size_t)T * HS * 2);
constexpr size_t WS_VT    = al256(WS_PROJ + (size_t)T * INW * 2);
constexpr size_t WS_ATT   = al256(WS_VT + (size_t)2 * 4 * 64 * SEQ * 2);
constexpr size_t WS_PG    = al256(WS_ATT + (size_t)T * 1024 * 2);
constexpr size_t WS_PP    = al256(WS_PG + (size_t)T * 1024 * 2);
constexpr size_t WS_MRGF  = al256(WS_PP + (size_t)T * 1024 * 2);
constexpr size_t WS_MRG   = al256(WS_MRGF + (size_t)T * D * 4);
constexpr size_t WS_MIX   = al256(WS_MRG + (size_t)T * D * 2);
constexpr size_t WS_LTOK  = al256(WS_MIX + (size_t)T * D * 4);
constexpr size_t WS_LW    = al256(WS_LTOK + (size_t)NE * T * 4);
constexpr size_t WS_TSLOT = al256(WS_LW + (size_t)NE * T * 4);
constexpr int    NPADROWS = T * 4 + NE * 256;
constexpr size_t WS_ACT   = al256(WS_TSLOT + (size_t)T * 4 * 4);
constexpr size_t WS_YB    = al256(WS_ACT + (size_t)NPADROWS * DFF * 2);
constexpr size_t WS_YB2   = al256(WS_YB + (size_t)NPADROWS * D * 2);
constexpr size_t WS_WBIN  = al256(WS_YB2 + (size_t)NPADROWS * D * 2);
constexpr size_t WS_WBA   = al256(WS_WBIN + (size_t)D * INW * 2);
constexpr size_t WS_WBO   = al256(WS_WBA + (size_t)1024 * D * 2);
constexpr size_t WS_END   = al256(WS_WBO + (size_t)D * D * 2);

constexpr int LDS_BAR  = 0;
constexpr int LDS_MAIN = 1024;
constexpr int LDS_A0 = LDS_MAIN, LDS_B0 = LDS_MAIN + 65536;
constexpr int LDS_TAB  = LDS_MAIN + 132096;
constexpr int LDS_BYTES = LDS_TAB + 4096;

struct Args {
    const float* in[22];
    float* out;
    unsigned char* ws;
    int ph_lo, ph_hi;
};

__device__ __forceinline__ unsigned pk_bf16(float lo, float hi) { f32x2 v = {lo, hi}; bf16x2_t b = __builtin_convertvector(v, bf16x2_t); return __builtin_bit_cast(unsigned, b); }
__device__ __forceinline__ float bf_lo(unsigned u) { return __uint_as_float(u << 16); }
__device__ __forceinline__ float bf_hi(unsigned u) { return __uint_as_float(u & 0xffff0000u); }
__device__ __forceinline__ float wave_sum(float v) {
#pragma unroll
    for (int o = 32; o >= 1; o >>= 1) v += __shfl_xor(v, o);
    return v;
}
__device__ __forceinline__ int swz(int r) { return (((r >> 1) ^ (r >> 4)) & 1) | (((r >> 2) & 1) << 1) | ((((r >> 3) ^ (r >> 5)) & 1) << 2); }

struct Wv { int tid, wid, lane, wm, wn, lr, lq; unsigned offA0, offB0, bw0, aw0; };

__device__ __forceinline__ void wv_init(Wv& w, int perm = 0) {
    w.tid = threadIdx.x; asm volatile("" : "+v"(w.tid));
    w.lane = w.tid & 63; w.wid = __builtin_amdgcn_readfirstlane(w.tid >> 6);
    w.wm = w.wid >> 2; w.wn = w.wid & 3; w.lr = w.lane & 15; w.lq = w.lane >> 4;
    const int v = w.lq ^ (w.lr >> 1);
    w.offA0 = (unsigned)((w.wm * 128 + w.lr) * 128 + (v << 4));
    w.offB0 = (unsigned)((w.wn * 64 + w.lr) * 128 + (v << 4));
    const int l = w.lane; const int rho = perm ? 64 * (l >> 4) + 32 * ((l >> 3) & 1) + 16 * (l & 1) + 4 * ((l >> 1) & 3) : 64 * (l >> 4) + 16 * (l & 3) + 4 * ((l >> 2) & 3);
    w.bw0 = (unsigned)(rho * 128 + ((w.wid ^ swz(rho)) << 4));
    { const int r0 = w.wid * 8 + (l >> 3); w.aw0 = (unsigned)(r0 * 128 + (((l & 7) ^ swz(r0)) << 4)); }
}
__device__ __forceinline__ int dma_row(const Wv& w, int p) { return p * 64 + w.wid * 8 + (w.lane >> 3); }
__device__ __forceinline__ int dma_chunk(const Wv& w, int p) { (void)p; return (w.lane & 7); }

#define KAPX(i, ks) (((((ks) << 2) ^ (((i) & 1) | (((i) & 2) << 1)))) << 4)

typedef int i32x4 __attribute__((ext_vector_type(4)));
__device__ __forceinline__ i32x4 mk_desc(const void* p, unsigned bytes) { const unsigned long long a = (unsigned long long)p; i32x4 d; d.x = __builtin_amdgcn_readfirstlane((int)(unsigned)a); d.y = __builtin_amdgcn_readfirstlane((int)((unsigned)(a >> 32) & 0xffffu)); d.z = __builtin_amdgcn_readfirstlane((int)bytes); d.w = 0x00020000; return d; }
__device__ __forceinline__ __amdgpu_buffer_rsrc_t mk_rsrc(const void* p, unsigned bytes) { return __builtin_amdgcn_make_buffer_rsrc((void*)p, (short)0, (int)bytes, 0x00020000); }

struct LoadDesc {
    const void* Ap; unsigned Abytes; unsigned arow[4]; int apitch64;
    const void* Wp; unsigned Wbytes; unsigned bvoff; int ldwb;
    int nkt;
    int nvalid;
};
template <class Sched, bool GATHER = false, bool WBF16 = false>
__device__ __forceinline__ void gemm_stream(LAS unsigned char* lds, const Sched& S) {
    typedef typename Sched::Epi Epi;
    Wv w; wv_init(w, Epi::PERM);
    LoadDesc cur, nxt; Epi ecur, enxt;
    if (!S.next(0, w, cur, ecur)) return;
    int ui = 1; bool has_nxt = S.next(1, w, nxt, enxt);
    f32x4 acc[8][4];
    f32x4 breg[WBF16 ? 1 : 8]; u32x2 bhr[WBF16 ? 8 : 1];
    u32x4 areg[4];
    bf16x8 afr[8], bfr[4];
    const int half = w.wm;
#define G_BAR() asm volatile("s_barrier" ::: "memory")
#define G_LGKM0() asm volatile("s_waitcnt lgkmcnt(0)" ::: "memory")
#define G_LDSEL(t2) const bool sel_ = ((t2) >= cur.nkt) && has_nxt; const int kt_ = ((t2) >= cur.nkt) ? (t2) - cur.nkt : (t2);
#define G_LDA(t2, h) do { G_LDSEL(t2) \
        const __amdgpu_buffer_rsrc_t ars_ = mk_rsrc(sel_ ? nxt.Ap : cur.Ap, sel_ ? nxt.Abytes : cur.Abytes); const int ap64_ = sel_ ? nxt.apitch64 : cur.apitch64; (void)ap64_; \
        _Pragma("unroll") for (int q = 0; q < 2; ++q) { const int p = 2 * (h) + q; const unsigned av_ = GATHER ? (sel_ ? nxt.arow[p] : cur.arow[p]) : (sel_ ? nxt.arow[0] : cur.arow[0]); \
            areg[p] = __builtin_bit_cast(u32x4, __builtin_amdgcn_raw_buffer_load_b128(ars_, av_, GATHER ? kt_ * 128 : kt_ * 128 + p * ap64_, 0)); } } while (0)
#define G_LDA1(t2, h, q) do { G_LDSEL(t2) \
        const __amdgpu_buffer_rsrc_t ars_ = mk_rsrc(sel_ ? nxt.Ap : cur.Ap, sel_ ? nxt.Abytes : cur.Abytes); const int ap64_ = sel_ ? nxt.apitch64 : cur.apitch64; (void)ap64_; \
        { const int p = 2 * (h) + (q); const unsigned av_ = GATHER ? (sel_ ? nxt.arow[p] : cur.arow[p]) : (sel_ ? nxt.arow[0] : cur.arow[0]); \
            areg[p] = __builtin_bit_cast(u32x4, __builtin_amdgcn_raw_buffer_load_b128(ars_, av_, GATHER ? kt_ * 128 : kt_ * 128 + p * ap64_, 0)); } } while (0)
#define G_LDB(t2, h, j0, j1) do { G_LDSEL(t2) \
        const __amdgpu_buffer_rsrc_t wrs_ = mk_rsrc(sel_ ? nxt.Wp : cur.Wp, sel_ ? nxt.Wbytes : cur.Wbytes); const int ldwb_ = sel_ ? nxt.ldwb : cur.ldwb; const unsigned bvo_ = sel_ ? nxt.bvoff : cur.bvoff; \
        _Pragma("unroll") for (int j = (j0); j < (j1); ++j) { if constexpr (WBF16) bhr[4 * (h) + j] = __builtin_bit_cast(u32x2, __builtin_amdgcn_raw_buffer_load_b64(wrs_, bvo_, (kt_ * 64 + 4 * (h) + j) * ldwb_, 0)); \
            else breg[4 * (h) + j] = __builtin_bit_cast(f32x4, __builtin_amdgcn_raw_buffer_load_b128(wrs_, bvo_, (kt_ * 64 + 4 * (h) + j) * ldwb_, 0)); } } while (0)
#define G_LD(t2, h) do { G_LDA(t2, h); G_LDB(t2, h, 0, 4); } while (0)
#define G_FENCE() asm volatile("" ::: "memory")
#define G_AWR(buf, h) do { _Pragma("unroll") for (int q = 0; q < 2; ++q) { const int p = 2 * (h) + q; \
        *(LAS u32x4*)(lds + LDS_A0 + (buf) * 32768 + w.aw0 + p * 8192) = areg[p]; } } while (0)
#define G_BWR(buf, h) do { _Pragma("unroll") for (int c = 0; c < 4; ++c) { u32x2 v_; \
        if constexpr (WBF16) { const unsigned sl_ = (c & 1) ? 0x07060302u : 0x05040100u; \
            v_.x = __builtin_amdgcn_perm(bhr[4 * (h) + 1][c >> 1], bhr[4 * (h)][c >> 1], sl_); v_.y = __builtin_amdgcn_perm(bhr[4 * (h) + 3][c >> 1], bhr[4 * (h) + 2][c >> 1], sl_); } \
        else { v_.x = pk_bf16(breg[WBF16 ? 0 : 4 * (h)][c], breg[WBF16 ? 0 : 4 * (h) + 1][c]); v_.y = pk_bf16(breg[WBF16 ? 0 : 4 * (h) + 2][c], breg[WBF16 ? 0 : 4 * (h) + 3][c]); } \
        *(LAS u32x2*)(lds + LDS_B0 + (buf) * 32768 + (w.bw0 ^ ((c >> 1) << 4)) + c * 128 + 8 * (h)) = v_; } } while (0)
#define G_FRAGB(buf, ks) do { \
        _Pragma("unroll") for (int j = 0; j < 4; ++j) bfr[j] = *(const LAS bf16x8*)(lds + LDS_B0 + (buf) * 32768 + (w.offB0 ^ KAPX(j, ks)) + j * 2048); } while (0)
#define G_FRAGA(buf, ks) do { \
        _Pragma("unroll") for (int i = 0; i < 8; ++i) afr[i] = *(const LAS bf16x8*)(lds + LDS_A0 + (buf) * 32768 + (w.offA0 ^ KAPX(i, ks)) + i * 2048); } while (0)
#define G_MMAR(i0, i1) do { if (ni) { _Pragma("unroll") for (int i = (i0); i < (i1); ++i) _Pragma("unroll") for (int j = 0; j < 4; ++j) \
        asm volatile("v_mfma_f32_16x16x32_bf16 %0, %1, %2, %0" : "+v"(acc[i][j]) : "v"(bfr[j]), "v"(afr[i])); } } while (0)
#define G_MMA0R(i0, i1) do { if (ni) { _Pragma("unroll") for (int i = (i0); i < (i1); ++i) _Pragma("unroll") for (int j = 0; j < 4; ++j) \
        asm volatile("v_mfma_f32_16x16x32_bf16 %0, %1, %2, 0" : "=v"(acc[i][j]) : "v"(bfr[j]), "v"(afr[i])); } } while (0)
#define G_MSEG(MM, t2, h) do { MM(0, 1); G_FENCE(); G_LDA1(t2, h, 0); G_FENCE(); MM(1, 2); G_FENCE(); G_LDA1(t2, h, 1); G_FENCE(); MM(2, 3); G_FENCE(); G_LDB(t2, h, 0, 1); G_FENCE(); MM(3, 4); G_FENCE(); G_LDB(t2, h, 1, 2); G_FENCE(); MM(4, 5); G_FENCE(); G_LDB(t2, h, 2, 3); G_FENCE(); MM(5, 6); G_FENCE(); G_LDB(t2, h, 3, 4); G_FENCE(); MM(6, 8); } while (0)
#define G_TILE0() do { \
          G_FRAGB(0, 0); G_AWR(1, 0); G_BWR(1, 0); G_FRAGA(0, 0); G_LGKM0(); G_BAR(); \
          G_MSEG(G_MMA0R, 2, 0); G_BAR(); \
          G_FRAGB(0, 1); G_AWR(1, 1); G_BWR(1, 1); G_FRAGA(0, 1); G_LGKM0(); G_BAR(); \
          G_MSEG(G_MMAR, 2, 1); G_BAR(); } while (0)
#define G_TILE(t, b) do { \
          G_FRAGB(b, 0); G_AWR((b) ^ 1, 0); G_BWR((b) ^ 1, 0); G_FRAGA(b, 0); G_LGKM0(); G_BAR(); \
          G_MSEG(G_MMAR, (t) + 2, 0); G_BAR(); \
          G_FRAGB(b, 1); G_AWR((b) ^ 1, 1); G_BWR((b) ^ 1, 1); G_FRAGA(b, 1); G_LGKM0(); G_BAR(); \
          G_MSEG(G_MMAR, (t) + 2, 1); G_BAR(); } while (0)
#define G_TILEX(t, b, skip) do { \
          G_FRAGB(b, 0); G_AWR((b) ^ 1, 0); G_BWR((b) ^ 1, 0); G_FRAGA(b, 0); G_LGKM0(); G_BAR(); \
          G_MSEG(G_MMAR, (t) + 2, 0); G_BAR(); \
          G_FRAGB(b, 1); G_AWR((b) ^ 1, 1); G_BWR((b) ^ 1, 1); G_FRAGA(b, 1); G_LGKM0(); G_BAR(); \
          G_MSEG(G_MMAR, (t) + 2, 1); if (!(skip)) G_BAR(); } while (0)

    G_LD(0, 0); G_LD(0, 1);
    G_AWR(0, 0); G_AWR(0, 1); G_BWR(0, 0); G_BWR(0, 1);
    G_LD(1, 0); G_LD(1, 1);
    G_LGKM0(); G_BAR();
    if (half == 1) G_BAR();
    if (half == 1) asm volatile("s_setprio 1");
#pragma unroll 1
    for (;;) {
        int ni = 1; if constexpr (Sched::ROWSKIP) ni = __builtin_amdgcn_readfirstlane((cur.nvalid > half * 128) ? 1 : 0);
        G_TILE0(); G_TILE(1, 1);
#pragma unroll 1
        for (int t = 2; t < cur.nkt; t += 2) { G_TILE(t, 0); G_TILEX(t + 1, 1, (half == 1) && (t + 2 >= cur.nkt)); }
        asm volatile("s_nop 15\n\ts_nop 15\n\ts_nop 15" ::: "memory");
        ecur(acc, w);
        if (!has_nxt) break;
        cur = nxt; ecur = enxt; ++ui; has_nxt = S.next(ui, w, nxt, enxt);
        if (half == 1) G_BAR();
    }
    asm volatile("s_setprio 0");
    __syncthreads();
#undef G_BAR
#undef G_LGKM0
#undef G_LD
#undef G_AWR
#undef G_BWR
#undef G_FRAGB
#undef G_FRAGA
#undef G_MMAR
#undef G_MMA0R
#undef G_MSEG
#undef G_LDA
#undef G_LDA1
#undef G_LDB
#undef G_LDSEL
#undef G_FENCE
#undef G_TILE0
#undef G_TILE
#undef G_TILEX
}

struct LaneXY { int lr, lq, wm, wn; };
__device__ __forceinline__ LaneXY opaque_xy(const Wv& w) { LaneXY q; int l = w.lane; asm volatile("" : "+v"(l)); q.lr = l & 15; q.lq = l >> 4; q.wm = w.wm; q.wn = w.wn; return q; }
#define PCOL(j, lq) (32 * ((j) >> 1) + 8 * (lq) + 4 * ((j) & 1))
__device__ __forceinline__ void st_row_bf16(bf16_t* rowp  , int lq, const f32x4& a0, const f32x4& a1, const f32x4& a2, const f32x4& a3) {
    u32x4 o0, o1; o0.x = pk_bf16(a0[0], a0[1]); o0.y = pk_bf16(a0[2], a0[3]); o0.z = pk_bf16(a1[0], a1[1]); o0.w = pk_bf16(a1[2], a1[3]);
    o1.x = pk_bf16(a2[0], a2[1]); o1.y = pk_bf16(a2[2], a2[3]); o1.z = pk_bf16(a3[0], a3[1]); o1.w = pk_bf16(a3[2], a3[3]);
    *(u32x4*)(rowp + 8 * lq) = o0; *(u32x4*)(rowp + 32 + 8 * lq) = o1;
}
struct EpiProj {
    static constexpr int PERM = 1;
    bf16_t* proj; bf16_t* vt; const float* bias; int m0, n0;
    __device__ __forceinline__ void operator()(f32x4 (&acc)[8][4], const Wv& w0) const { const LaneXY w = opaque_xy(w0);
        const int colw = n0 + w.wn * 64;
        f32x4 bv[4];
#pragma unroll
        for (int j = 0; j < 4; ++j) bv[j] = *(const f32x4*)(bias + colw + PCOL(j, w.lq));
        if (n0 == 1280) {
#pragma unroll
            for (int i = 0; i < 8; ++i) { const int row = m0 + w.wm * 128 + i * 16 + w.lr; const int b = row >> 12, sq = row & 4095;
#pragma unroll
                for (int j = 0; j < 4; ++j)
#pragma unroll
                    for (int e = 0; e < 4; ++e) { const int d = PCOL(j, w.lq) + e; const float v = acc[i][j][e] + bv[j][e];
                        vt[((size_t)((b * 4 + w.wn) * 64 + d)) * SEQ + sq] = (bf16_t)(pk_bf16(v, 0.f) & 0xffffu); } }
            return;
        }
        const float qs = (n0 < 1024) ? 0.125f * LOG2E : 1.0f;
        const bool sig = n0 >= 2560;
#pragma unroll
        for (int i = 0; i < 8; ++i) { const int row = m0 + w.wm * 128 + i * 16 + w.lr;
            f32x4 v[4];
#pragma unroll
            for (int j = 0; j < 4; ++j)
#pragma unroll
                for (int e = 0; e < 4; ++e) { float x = (acc[i][j][e] + bv[j][e]) * qs; if (sig) x = __builtin_amdgcn_rcpf(1.0f + __builtin_amdgcn_exp2f(-LOG2E * x)); v[j][e] = x; }
            st_row_bf16(proj + (size_t)row * INW + colw, w.lq, v[0], v[1], v[2], v[3]); }
    }
};
struct EpiWc {
    static constexpr int PERM = 1;
    bf16_t* wc; int r0, n0;
    __device__ __forceinline__ void operator()(f32x4 (&acc)[8][4], const Wv& w0) const { const LaneXY w = opaque_xy(w0);
        const int colw = n0 + w.wn * 64;
#pragma unroll
        for (int i = 0; i < 8; ++i) { const int row = r0 + w.wm * 128 + i * 16 + w.lr; st_row_bf16(wc + (size_t)row * D + colw, w.lq, acc[i][0], acc[i][1], acc[i][2], acc[i][3]); }
    }
};
struct EpiBranch {
    static constexpr int PERM = 1;
    bf16_t* part; bf16_t* mrg; const bf16_t* proj; int m0, n0, second;
    __device__ __forceinline__ void operator()(f32x4 (&acc)[8][4], const Wv& w0) const { const LaneXY w = opaque_xy(w0);
        const int colw = n0 + w.wn * 64;
        if (second) asm volatile("s_waitcnt vmcnt(0)" ::: "memory");
#pragma unroll
        for (int i = 0; i < 8; ++i) { const int row = m0 + w.wm * 128 + i * 16 + w.lr;
            const bf16_t* gp = proj + (size_t)row * INW + 2560 + second * 2048 + colw;
            const u32x4 g0 = *(const u32x4*)(gp + 8 * w.lq), g1 = *(const u32x4*)(gp + 32 + 8 * w.lq);
            const unsigned gw[8] = {g0.x, g0.y, g0.z, g0.w, g1.x, g1.y, g1.z, g1.w};
            f32x4 r[4];
#pragma unroll
            for (int j = 0; j < 4; ++j) { f32x4 g = {bf_lo(gw[2 * j]), bf_hi(gw[2 * j]), bf_lo(gw[2 * j + 1]), bf_hi(gw[2 * j + 1])}; r[j] = acc[i][j] * g; }
            bf16_t* pp_ = part + (size_t)row * D + colw;
            if (second == 0) { st_row_bf16(pp_, w.lq, r[0], r[1], r[2], r[3]); }
            else {
                const u32x4 p0 = *(const u32x4*)(pp_ + 8 * w.lq), p1 = *(const u32x4*)(pp_ + 32 + 8 * w.lq);
                const unsigned pw[8] = {p0.x, p0.y, p0.z, p0.w, p1.x, p1.y, p1.z, p1.w};
#pragma unroll
                for (int j = 0; j < 4; ++j) { r[j][0] += bf_lo(pw[2 * j]); r[j][1] += bf_hi(pw[2 * j]); r[j][2] += bf_lo(pw[2 * j + 1]); r[j][3] += bf_hi(pw[2 * j + 1]); }
                st_row_bf16(mrg + (size_t)row * D + colw, w.lq, r[0], r[1], r[2], r[3]);
            } }
    }
};
struct EpiOut {
    static constexpr int PERM = 1;
    bf16_t* mix; int m0, n0;
    __device__ __forceinline__ void operator()(f32x4 (&acc)[8][4], const Wv& w0) const { const LaneXY w = opaque_xy(w0);
        const int colw = n0 + w.wn * 64;
#pragma unroll
        for (int i = 0; i < 8; ++i) { const int row = m0 + w.wm * 128 + i * 16 + w.lr; st_row_bf16(mix + (size_t)row * D + colw, w.lq, acc[i][0], acc[i][1], acc[i][2], acc[i][3]); }
    }
};
struct EpiSwiglu {
    static constexpr int PERM = 0;
    bf16_t* act; const float* bias; int orow0, n0, nv;
    __device__ __forceinline__ void operator()(f32x4 (&acc)[8][4], const Wv& w0) const { const LaneXY w = opaque_xy(w0);
        const int colb = n0 + w.wn * 64 + 16 * w.lq;
        f32x4 bv[4];
#pragma unroll
        for (int j = 0; j < 4; ++j) bv[j] = *(const f32x4*)(bias + colb + 4 * j);
#pragma unroll
        for (int i = 0; i < 8; ++i) { const int row = orow0 + w.wm * 128 + i * 16 + w.lr;
            float o[8];
#pragma unroll
            for (int j = 0; j < 4; ++j)
#pragma unroll
                for (int h = 0; h < 2; ++h) { float xg = acc[i][j][2 * h] + bv[j][2 * h], xl = acc[i][j][2 * h + 1] + bv[j][2 * h + 1];
                    xg = fminf(xg, 7.0f); xl = fminf(fmaxf(xl, -7.0f), 7.0f);
                    o[2 * j + h] = xg * __builtin_amdgcn_rcpf(1.0f + __builtin_amdgcn_exp2f((-1.702f * LOG2E) * xg)) * (xl + 1.0f); }
            u32x4 ov; ov.x = pk_bf16(o[0], o[1]); ov.y = pk_bf16(o[2], o[3]); ov.z = pk_bf16(o[4], o[5]); ov.w = pk_bf16(o[6], o[7]);
            if (w.wm * 128 + i * 16 + w.lr < nv) *(u32x4*)(act + (size_t)row * DFF + (colb >> 1)) = ov; }
    }
};
struct EpiDown {
    static constexpr int PERM = 1;
    bf16_t* yb; const float* bias; const float* lw; int orow0, n0, s0, cnt; float bsc;
    __device__ __forceinline__ void operator()(f32x4 (&acc)[8][4], const Wv& w0) const { const LaneXY w = opaque_xy(w0);
        const int colw = n0 + w.wn * 64;
        f32x4 bv[4];
#pragma unroll
        for (int j = 0; j < 4; ++j) bv[j] = *(const f32x4*)(bias + colw + PCOL(j, w.lq)) * bsc;
#pragma unroll
        for (int i = 0; i < 8; ++i) { const int r = w.wm * 128 + i * 16 + w.lr; const int sl = s0 + r; const float rw = (sl < cnt) ? lw[sl] : 0.f;
            if (sl < cnt) st_row_bf16(yb + (size_t)(orow0 + r) * D + colw, w.lq, (acc[i][0] + bv[0]) * rw, (acc[i][1] + bv[1]) * rw, (acc[i][2] + bv[2]) * rw, (acc[i][3] + bv[3]) * rw); }
    }
};

__device__ __forceinline__ void moe_tables(LAS unsigned char* lds, const unsigned* cntg) {
    LAS int* tab = (LAS int*)(lds + LDS_TAB);
    const int t = threadIdx.x;
    if (t < 64) {
        const int c = (t < 32) ? (int)cntg[16 * (t & 31)] : 0; const int nt = (c + 255) >> 8;
        int incl = nt;
#pragma unroll
        for (int o = 1; o < 32; o <<= 1) { const int v = __shfl_up(incl, o, 64); if (t >= o) incl += v; }
        if (t < 32) { tab[t] = c; tab[32 + t] = nt; tab[64 + t] = incl - nt; }
        if (t == 31) tab[96] = incl; }
    __syncthreads();
}
__device__ __forceinline__ void moe_decode(LAS unsigned char* lds, int u, int NN, int& e, int& ti, int& pn) {
    const LAS int* tab = (const LAS int*)(lds + LDS_TAB);
    const int ln = (int)(threadIdx.x & 63u);
    const bool past = (ln < 32) && (u >= tab[64 + ln + 1] * NN);
    int ee = __builtin_popcountll(__ballot(past)); if (ee > 31) ee = 31;
    const int rem = u - tab[64 + ee] * NN, nt = tab[32 + ee];
    const int pn_ = rem / nt;
    e = __builtin_amdgcn_readfirstlane(ee); pn = __builtin_amdgcn_readfirstlane(pn_); ti = __builtin_amdgcn_readfirstlane(rem - pn_ * nt);
}

__device__ __forceinline__ void ld_dense(LoadDesc& L, const Wv& w, const void* Ap, unsigned Abytes, int row0, int pitchB, int colB, const void* Wp, unsigned Wbytes, int ldw, int k0, int n0, int nkt, int wes = 4  ) {
    L.Ap = Ap; L.Abytes = Abytes; L.arow[0] = (unsigned)((row0 + dma_row(w, 0)) * pitchB + colB + dma_chunk(w, 0) * 16); L.arow[1] = 0u; L.arow[2] = 0u; L.arow[3] = 0u; L.apitch64 = 64 * pitchB;
    L.Wp = Wp; L.Wbytes = Wbytes; L.bvoff = (unsigned)(((w.wid * 8 + k0) * ldw + n0 + 4 * w.lane) * wes); L.ldwb = ldw * wes; L.nkt = nkt; L.nvalid = 256;
}
struct SchedProj {
    static constexpr bool ROWSKIP = false;
    typedef EpiProj Epi;
    const bf16_t* hbuf; const bf16_t* w_in; bf16_t* proj; bf16_t* vt; const float* b_in; int first, stride, count;
    __device__ __forceinline__ bool next(int i, const Wv& w, LoadDesc& L, Epi& E) const {
        if (i >= count) return false;
        const int u = first + i * stride; const int v = u % 104; const int pm = (u / 104) * 4 + (v & 3), pn = v >> 2; const int m0 = pm * 256, n0 = pn * 256;
        ld_dense(L, w, hbuf, (unsigned)((size_t)T * HS * 2), m0, HS * 2, 0, w_in, (unsigned)((size_t)D * INW * 2), INW, 0, n0, D / 64, 2);
        E = EpiProj{proj, vt, b_in, m0, n0}; return true; }
};
struct SchedWc {
    static constexpr bool ROWSKIP = false;
    typedef EpiWc Epi;
    const bf16_t* wms; const float* w_pool_branch; bf16_t* wc; int g, n0;
    __device__ __forceinline__ bool next(int i, const Wv& w, LoadDesc& L, Epi& E) const {
        if (i >= 1) return false;
        ld_dense(L, w, wms, 4u * 256u * 256u * 2u, g * 256, 512, 0, w_pool_branch + (size_t)g * 256 * D, 256u * 2048u * 4u, D, 0, n0, 4);
        E = EpiWc{wc, g * 256, n0}; return true; }
};
struct SchedBranch {
    static constexpr bool ROWSKIP = false;
    typedef EpiBranch Epi;
    const bf16_t* att; const bf16_t* pg; const bf16_t* w_a; const bf16_t* wc; bf16_t* mrgf; bf16_t* mrg; const bf16_t* proj; int first, stride, count;
    __device__ __forceinline__ bool next(int i, const Wv& w, LoadDesc& L, Epi& E) const {
        if (i >= 2 * count) return false;
        const int u = first + (i >> 1) * stride, second = i & 1; const int v = u & 31; const int pm = (u >> 5) * 4 + (v & 3), pn = v >> 2; const int m0 = pm * 256, n0 = pn * 256;
        ld_dense(L, w, second ? pg : att, (unsigned)((size_t)T * 1024 * 2), m0, 2048, 0, second ? wc : w_a, 1024u * 2048u * 2u, D, 0, n0, 16, 2);
        E = EpiBranch{mrgf, mrg, proj, m0, n0, second}; return true; }
};
struct SchedOut {
    static constexpr bool ROWSKIP = false;
    typedef EpiOut Epi;
    const bf16_t* mrg; const bf16_t* w_out; bf16_t* mix; int first, stride, count;
    __device__ __forceinline__ bool next(int i, const Wv& w, LoadDesc& L, Epi& E) const {
        if (i >= count) return false;
        const int u = first + i * stride; const int v = u & 31; const int pm = (u >> 5) * 4 + (v & 3), pn = v >> 2; const int m0 = pm * 256, n0 = pn * 256;
        ld_dense(L, w, mrg, (unsigned)((size_t)T * D * 2), m0, D * 2, 0, w_out, 2048u * 2048u * 2u, D, 0, n0, D / 64, 2);
        E = EpiOut{mix, m0, n0}; return true; }
};
struct SchedGateUp {
    static constexpr bool ROWSKIP = false;
    typedef EpiSwiglu Epi;
    LAS unsigned char* lds; const bf16_t* hbuf; const int* ltok; const float* w_gate_up; const float* b_gate_up; bf16_t* act; int first, stride, uend;
    __device__ __forceinline__ bool next(int i, const Wv& w, LoadDesc& L, Epi& E) const {
        const int u = first + i * stride; if (u >= uend) return false;
        const LAS int* tab = (const LAS int*)(lds + LDS_TAB);
        int e, ti, pn; moe_decode(lds, u, 16, e, ti, pn);
        const int cnt = __builtin_amdgcn_readfirstlane(tab[e]), s0 = ti * 256, orow0 = __builtin_amdgcn_readfirstlane(tab[64 + e]) * 256 + s0, n0 = pn * 256;
        L.Ap = hbuf; L.Abytes = (unsigned)((size_t)T * HS * 2); L.apitch64 = 0;
        { unsigned tk[4];
#pragma unroll
          for (int p = 0; p < 4; ++p) { const int sl = s0 + dma_row(w, p); tk[p] = (sl < cnt) ? (unsigned)ltok[e * T + sl] * (unsigned)(HS * 2) + (unsigned)((w.lane & 7) * 16) : 0xfffffff0u; }
          L.arow[0] = tk[0]; L.arow[1] = tk[1]; L.arow[2] = tk[2]; L.arow[3] = tk[3]; }
        L.Wp = w_gate_up + (size_t)e * 2048 * 4096; L.Wbytes = 2048u * 4096u * 4u; L.bvoff = (unsigned)(((w.wid * 8) * 4096 + n0 + 4 * w.lane) * 4); L.ldwb = 4096 * 4; L.nkt = D / 64; L.nvalid = (cnt - s0 < 256) ? cnt - s0 : 256;
        E = EpiSwiglu{act, b_gate_up + (size_t)e * 4096, orow0, n0, (cnt - s0 < 256) ? cnt - s0 : 256}; return true; }
};
struct SchedDown {
    static constexpr bool ROWSKIP = false;
    typedef EpiDown Epi;
    LAS unsigned char* lds; const bf16_t* act; const float* lw; const float* w_down; const float* b_down; bf16_t* yb; bf16_t* yb2; unsigned char* sflag; int first, stride, nfull, last, lastkh;
    __device__ __forceinline__ bool next(int i, const Wv& w, LoadDesc& L, Epi& E) const {
        if (i > nfull || (i == nfull && last < 0)) return false;
        const bool fin = (i == nfull); const int u = fin ? last : first + i * stride; const int kh = fin ? lastkh : -1;
        const LAS int* tab = (const LAS int*)(lds + LDS_TAB);
        int e, ti, pn; moe_decode(lds, u, 8, e, ti, pn);
        const int cnt = __builtin_amdgcn_readfirstlane(tab[e]), s0 = ti * 256, tile = __builtin_amdgcn_readfirstlane(tab[64 + e]) + ti, orow0 = tile * 256, n0 = pn * 256;
        const int k0 = (kh > 0) ? 1024 : 0;
        ld_dense(L, w, act, (unsigned)((size_t)NPADROWS * DFF * 2), orow0, DFF * 2, k0 * 2, w_down + (size_t)e * 2048 * 2048, 2048u * 2048u * 4u, 2048, k0, n0, (kh >= 0) ? 16 : 32);
        L.nvalid = (cnt - s0 < 256) ? cnt - s0 : 256;
#pragma unroll
        for (int p = 0; p < 4; ++p) { const int r = dma_row(w, p); L.arow[p] = (s0 + r < cnt) ? (unsigned)((orow0 + r) * (DFF * 2) + k0 * 2 + dma_chunk(w, p) * 16) : 0xfffffff0u; }
        L.apitch64 = 0;
        if (kh >= 0 && w.wid == 0 && w.lane == 0) sflag[tile * 8 + pn] = 1;
        E = EpiDown{(kh > 0) ? yb2 : yb, b_down + (size_t)e * 2048, lw + (size_t)e * T, orow0, n0, s0, cnt, (kh > 0) ? 0.f : 1.f}; return true; }
};

template <int WL>
__device__ __forceinline__ void pool_run(const bf16_t* proj, bf16_t* pg, int tok0, int ch) {
    const int tin0 = tok0 & (SEQ - 1);
    const bf16_t* base = proj + (size_t)tok0 * INW + 1536 + ch * 8;
    u32x4 r[WL + 7];
#pragma unroll
    for (int j = 0; j < WL + 7; ++j) { const int d = j - (WL - 1); r[j] = (u32x4){0u, 0u, 0u, 0u}; if (d >= 0 || tin0 + d >= 0) r[j] = *(const u32x4*)(base + (long)d * INW); }
    float s[8];
#pragma unroll
    for (int e = 0; e < 8; ++e) s[e] = 0.f;
#pragma unroll
    for (int j = 0; j < WL; ++j) { s[0] += bf_lo(r[j].x); s[1] += bf_hi(r[j].x); s[2] += bf_lo(r[j].y); s[3] += bf_hi(r[j].y); s[4] += bf_lo(r[j].z); s[5] += bf_hi(r[j].z); s[6] += bf_lo(r[j].w); s[7] += bf_hi(r[j].w); }
#pragma unroll
    for (int t = 0; t < 8; ++t) {
        if (t > 0) { const u32x4 a = r[WL - 1 + t], b = r[t - 1];
            s[0] += bf_lo(a.x) - bf_lo(b.x); s[1] += bf_hi(a.x) - bf_hi(b.x); s[2] += bf_lo(a.y) - bf_lo(b.y); s[3] += bf_hi(a.y) - bf_hi(b.y);
            s[4] += bf_lo(a.z) - bf_lo(b.z); s[5] += bf_hi(a.z) - bf_hi(b.z); s[6] += bf_lo(a.w) - bf_lo(b.w); s[7] += bf_hi(a.w) - bf_hi(b.w); }
        const int n = (tin0 + t + 1 < WL) ? tin0 + t + 1 : WL; const float rn = 1.0f / (float)n; const u32x4 u0 = r[WL - 1 + t];
        u32x4 ov; ov.x = pk_bf16(s[0] * rn - bf_lo(u0.x), s[1] * rn - bf_hi(u0.x)); ov.y = pk_bf16(s[2] * rn - bf_lo(u0.y), s[3] * rn - bf_hi(u0.y));
        ov.z = pk_bf16(s[4] * rn - bf_lo(u0.z), s[5] * rn - bf_hi(u0.z)); ov.w = pk_bf16(s[6] * rn - bf_lo(u0.w), s[7] * rn - bf_hi(u0.w));
        *(u32x4*)(pg + (size_t)(tok0 + t) * 1024 + ch * 8) = ov; }
}

__global__ void __launch_bounds__(512, 2) mk_fwd(Args args) {
    extern __shared__ __attribute__((aligned(16))) unsigned char lds_raw[];
    LAS unsigned char* lds = (LAS unsigned char*)lds_raw;
    const int tid = threadIdx.x, lane = tid & 63, wid = __builtin_amdgcn_readfirstlane(tid >> 6), blk = blockIdx.x;
#define PHASE_IDS() int tid_o_ = threadIdx.x; asm volatile("" : "+v"(tid_o_)); const int tid = tid_o_, lane = tid & 63, wid = __builtin_amdgcn_readfirstlane(tid >> 6); (void)tid; (void)lane; (void)wid
    unsigned char* ws = args.ws;
    const float* x = args.in[0]; const float* cvec = args.in[1]; const float* w_mod = args.in[2]; const float* b_mod = args.in[3];
    const float* g_pre_mix = args.in[4]; const float* g_post_mix = args.in[5]; const float* w_in = args.in[6]; const float* b_in = args.in[7];
    const float* sinks = args.in[8]; const float* w_pool_mix = args.in[9]; const float* pool_scale = args.in[10];
    const float* w_attn_branch = args.in[11]; const float* w_pool_branch = args.in[12]; const float* w_out = args.in[13];
    const float* g_pre_ffn = args.in[14]; const float* g_post_ffn = args.in[15]; const float* w_router = args.in[16]; const float* b_router = args.in[17];
    const float* w_gate_up = args.in[18]; const float* b_gate_up = args.in[19]; const float* w_down = args.in[20]; const float* b_down = args.in[21];
    float* out = args.out;
    unsigned* ctl = (unsigned*)(ws + WS_CTL);
    unsigned* cntg = (unsigned*)(ws + WS_CTL + CTL_CNT_OFF);
    float* modv = (float*)(ws + WS_MOD);
    bf16_t* wrt = (bf16_t*)(ws + WS_WRT);
    bf16_t* hbuf = (bf16_t*)(ws + WS_H);
    bf16_t* proj = (bf16_t*)(ws + WS_PROJ);
    bf16_t* x1b = (bf16_t*)(ws + WS_PROJ);
    bf16_t* vt = (bf16_t*)(ws + WS_VT);
    bf16_t* att = (bf16_t*)(ws + WS_ATT);
    bf16_t* pg = (bf16_t*)(ws + WS_PG);
    bf16_t* wc = (bf16_t*)(ws + WS_PP);
    bf16_t* wms = (bf16_t*)(ws + WS_WMS);
    bf16_t* mrgf = (bf16_t*)(ws + WS_MRGF);
    bf16_t* mrg = (bf16_t*)(ws + WS_MRG);
    bf16_t* mix = (bf16_t*)(ws + WS_MIX);
    int* ltok = (int*)(ws + WS_LTOK);
    float* lw = (float*)(ws + WS_LW);
    int* tslot = (int*)(ws + WS_TSLOT);
    bf16_t* act = (bf16_t*)(ws + WS_ACT);
    bf16_t* yb = (bf16_t*)(ws + WS_YB);
    bf16_t* yb2 = (bf16_t*)(ws + WS_YB2);
    bf16_t* wbin = (bf16_t*)(ws + WS_WBIN); bf16_t* wba = (bf16_t*)(ws + WS_WBA); bf16_t* wbo = (bf16_t*)(ws + WS_WBO);
    unsigned char* sflag = (unsigned char*)(ws + WS_CTL + CTL_FLAG_OFF);

    if (tid < 4) ((LAS unsigned*)(lds + LDS_BAR))[tid] = 0u;
    __syncthreads();
    XcdBarrier bar; bar.bar = ctl; bar.x = 0; bar.st = nullptr;
    if (MK_N_LAUNCHES == 1) bar = xcd_barrier_post(ctl, (volatile LAS unsigned*)(lds + LDS_BAR));
    if (MK_N_LAUNCHES == 1 && tid == 0) { const unsigned xx = xb_xcc_id(); ((LAS unsigned*)(lds + LDS_BAR))[2] = xx; ((LAS unsigned*)(lds + LDS_BAR))[3] = xb_add((unsigned*)(ws + WS_CTL + CTL_RANK_OFF) + 64 * xx, 1u); }
    __syncthreads();
    const int lo = args.ph_lo, hi = args.ph_hi;
#ifndef PH_MASK
#define PH_MASK 0x7ff
#endif
#ifndef REP_MASK
#define REP_MASK 0
#endif
#define REPS(k) ((((REP_MASK) >> (k)) & 1) ? 2 : 1)
#define IN(k) ((((PH_MASK) >> (k)) & 1) && lo <= (k) && (k) < hi)
#define SEAM(k) do { if (IN(k) && IN((k) + 1)) xcd_barrier(bar); } while (0)

    int xcd = blk & 7, rnk = blk >> 3, nxcd = 8, npx = (int)gridDim.x >> 3;
#define XCD_SETUP() do { if (MK_N_LAUNCHES == 1) { const LAS unsigned* st_ = (const LAS unsigned*)(lds + LDS_BAR); \
        xcd = __builtin_amdgcn_readfirstlane((int)st_[2]); rnk = __builtin_amdgcn_readfirstlane((int)st_[3]); npx = __builtin_amdgcn_readfirstlane((int)st_[0]); nxcd = __builtin_amdgcn_readfirstlane((int)st_[1]); \
        if (npx < 1) npx = 1; if (nxcd < 1) nxcd = 1; } } while (0)

    if (IN(0)) for (int rep_ = 0; rep_ < REPS(0); ++rep_) { PHASE_IDS();
        LAS float* sc = (LAS float*)(lds + LDS_MAIN);
        LAS float* part = (LAS float*)(lds + LDS_MAIN + 16384);
        for (int i = tid; i < 4096; i += 512) { const float cv = cvec[i]; sc[i] = cv / (1.0f + __expf(-cv)); }
        __syncthreads();
        { const int j0 = 16 * blk;
          if (tid < 504) {
            const int q = tid & 3, kl = tid >> 2;
            f32x4 a0 = {0.f, 0.f, 0.f, 0.f}, a1 = {0.f, 0.f, 0.f, 0.f};
            const float* wp = w_mod + j0 + 4 * q;
#pragma unroll 4
            for (int k = kl; k < 2048; k += 126) { const f32x4 wv4 = *(const f32x4*)(wp + (size_t)k * 12288); a0 += wv4 * sc[k]; a1 += wv4 * sc[2048 + k]; }
#pragma unroll
            for (int e = 0; e < 4; ++e) { part[kl * 32 + q * 4 + e] = a0[e]; part[kl * 32 + 16 + q * 4 + e] = a1[e]; }
          }
          __syncthreads();
          if (tid < 32) { float s = 0.f; for (int kl = 0; kl < 126; ++kl) s += part[kl * 32 + tid]; const int b = tid >> 4, jj = tid & 15; modv[b * 12288 + j0 + jj] = s + b_mod[j0 + jj]; } }
        { const int gt = blk * 512 + tid;
          for (int i = gt; i < D * INW / 8; i += 131072) { const f32x4 a = *(const f32x4*)(w_in + (size_t)i * 8), b = *(const f32x4*)(w_in + (size_t)i * 8 + 4); u32x4 o; o.x = pk_bf16(a[0], a[1]); o.y = pk_bf16(a[2], a[3]); o.z = pk_bf16(b[0], b[1]); o.w = pk_bf16(b[2], b[3]); *(u32x4*)(wbin + (size_t)i * 8) = o; }
          for (int i = gt; i < 1024 * D / 8; i += 131072) { const f32x4 a = *(const f32x4*)(w_attn_branch + (size_t)i * 8), b = *(const f32x4*)(w_attn_branch + (size_t)i * 8 + 4); u32x4 o; o.x = pk_bf16(a[0], a[1]); o.y = pk_bf16(a[2], a[3]); o.z = pk_bf16(b[0], b[1]); o.w = pk_bf16(b[2], b[3]); *(u32x4*)(wba + (size_t)i * 8) = o; }
          for (int i = gt; i < D * D / 8; i += 131072) { const f32x4 a = *(const f32x4*)(w_out + (size_t)i * 8), b = *(const f32x4*)(w_out + (size_t)i * 8 + 4); u32x4 o; o.x = pk_bf16(a[0], a[1]); o.y = pk_bf16(a[2], a[3]); o.z = pk_bf16(b[0], b[1]); o.w = pk_bf16(b[2], b[3]); *(u32x4*)(wbo + (size_t)i * 8) = o; } }
        for (int i = blk * 512 + tid; i < 4 * 65536; i += 131072) { const int g = i >> 16, d = i & 255; wms[i] = (bf16_t)(pk_bf16(w_pool_mix[i] * pool_scale[g * 256 + d], 0.f) & 0xffffu); }
        { const int i = blk * 512 + tid; if (i < 65536) { const int e = i & 31, k = i >> 5; wrt[e * 2048 + k] = (bf16_t)(pk_bf16(w_router[i], 0.f) & 0xffffu); } }
        __syncthreads();
    }
    SEAM(0);
    if (MK_N_LAUNCHES == 1 && IN(0) && IN(1)) {
        if (threadIdx.x == 0) { LAS unsigned* st_ = (LAS unsigned*)(lds + LDS_BAR); const unsigned hx_ = st_[2]; unsigned ord_ = 0;
            for (unsigned j = 0; j < 16; ++j) { const unsigned c_ = ctl[XB_XCNT(j)]; if (j < hx_ && c_ > 0u) ++ord_; }
            st_[2] = ord_; }
        __syncthreads();
    }

    if (IN(1)) for (int rep_ = 0; rep_ < REPS(1); ++rep_) { PHASE_IDS();
        { const int rowb = blk * 32 + wid * 4; const int b = rowb >> 12;
          f32x4 cgs[8], csh[8];
#pragma unroll
          for (int j = 0; j < 8; ++j) { const int col = 4 * lane + 256 * j; cgs[j] = *(const f32x4*)(g_pre_mix + col) * (*(const f32x4*)(modv + b * 12288 + 2048 + col) + 1.0f); csh[j] = *(const f32x4*)(modv + b * 12288 + col); }
          f32x4 xw[2][8];
#pragma unroll
          for (int j = 0; j < 8; ++j) xw[0][j] = *(const f32x4*)(x + (size_t)rowb * D + 4 * lane + 256 * j);
#pragma unroll
          for (int rr = 0; rr < 4; ++rr) { const int sb = rr & 1; const int row = rowb + rr;
            if (rr < 3) {
#pragma unroll
                for (int j = 0; j < 8; ++j) xw[sb ^ 1][j] = *(const f32x4*)(x + (size_t)(row + 1) * D + 4 * lane + 256 * j); }
            float ss = 0.f;
#pragma unroll
            for (int j = 0; j < 8; ++j) { const f32x4 xv = xw[sb][j]; ss += xv[0] * xv[0] + xv[1] * xv[1] + xv[2] * xv[2] + xv[3] * xv[3]; }
            ss = wave_sum(ss); const float r = rsqrtf(ss * (1.0f / D) + RMS_EPS);
#pragma unroll
            for (int j = 0; j < 8; ++j) { const int col = 4 * lane + 256 * j;
                const f32x4 h = xw[sb][j] * r * cgs[j] + csh[j];
                u32x2 o; o.x = pk_bf16(h[0], h[1]); o.y = pk_bf16(h[2], h[3]); *(u32x2*)(hbuf + (size_t)row * HS + col) = o; }
          } }
    }
    SEAM(1);

    if (IN(2)) for (int rep_ = 0; rep_ < REPS(2); ++rep_) { PHASE_IDS();
        XCD_SETUP();
        const int U = 32 * 26; const int ulo = (U * xcd) / nxcd, uhi = (U * (xcd + 1)) / nxcd;
        { int cnt3 = 0; for (int k = 0; k < 3; ++k) if (ulo + rnk + k * npx < uhi) ++cnt3;
          SchedProj S{hbuf, wbin, proj, vt, b_in, ulo + rnk, npx, cnt3}; gemm_stream<SchedProj, false, true>(lds, S); }
    }
    SEAM(2);

    if (IN(3)) for (int rep_ = 0; rep_ < REPS(3); ++rep_) { PHASE_IDS();
        XCD_SETUP();
        int nleft, wk, nwk;
        { const int U = 32 * 26; const int ulo = (U * xcd) / nxcd, uhi = (U * (xcd + 1)) / nxcd; nleft = uhi - ulo - 3 * npx; if (nleft < 0) nleft = 0; if (nleft > npx - 1) nleft = npx - 1;
          if (rnk < nleft) { int c = 0; for (int u = ulo + 3 * npx + rnk; u < uhi; u += nleft) ++c; SchedProj S{hbuf, wbin, proj, vt, b_in, ulo + 3 * npx + rnk, nleft, c}; gemm_stream<SchedProj, false, true>(lds, S); }
          wk = rnk - nleft; nwk = npx - nleft; }
        const int alo = (256 * xcd) / nxcd, ahi = (256 * (xcd + 1)) / nxcd;
        if (wk >= 0) for (int u = alo + wk; u < ahi; u += nwk) {
            const int b = u >> 7, nb = (u >> 2) & 31, kvh = u & 3;
            const int tok0 = b * SEQ + nb * 128;
            LAS unsigned char* Kl = lds + LDS_MAIN;
            LAS unsigned char* Vl = lds + LDS_MAIN + 32768;
            __syncthreads();
#pragma unroll
            for (int p = 0; p < 4; ++p) { const int q = tid + 512 * p; const int row = q >> 3, ch = q & 7; const bool ok = (nb > 0) || (row >= 128);
                u32x4 v = {0u, 0u, 0u, 0u};
                if (ok) v = *(const u32x4*)(proj + (size_t)(tok0 - 128 + row) * INW + 1024 + kvh * 64 + ch * 8);
                *(LAS u32x4*)(Kl + row * 128 + ((ch ^ swz(row)) << 4)) = v; }
#pragma unroll
            for (int p = 0; p < 4; ++p) { const int q = tid + 512 * p; const int d = q >> 5, ch = q & 31; const bool ok = (nb > 0) || (ch >= 16);
                u32x4 v = {0u, 0u, 0u, 0u};
                if (ok) v = *(const u32x4*)(vt + ((size_t)((b * 4 + kvh) * 64 + d)) * SEQ + (nb * 128 - 128 + ch * 8));
                *(LAS u32x4*)(Vl + d * 528 + ch * 16) = v; }
            __syncthreads();
            const int g = wid >> 1, half = wid & 1, hq = kvh * 4 + g;
            const float sink2 = sinks[hq] * LOG2E;
            const int lr = lane & 15, lq = lane >> 4;
#pragma unroll 1
            for (int a4 = 0; a4 < 4; ++a4) {
                const int a = half * 4 + a4; const int qrow = tok0 + 16 * a + lr; const int p0 = a >> 1;
                bf16x8 qf[2];
#pragma unroll
                for (int ks = 0; ks < 2; ++ks) qf[ks] = *(const bf16x8*)(proj + (size_t)qrow * INW + hq * 64 + ks * 32 + lq * 8);
                f32x4 s[10];
#pragma unroll
                for (int ff = 0; ff < 10; ++ff) { const int krow = 16 * (2 * p0 + ff) + lr; const int sw = swz(krow);
                    const bf16x8 k0 = *(const LAS bf16x8*)(Kl + krow * 128 + (((0 + lq) ^ sw) << 4));
                    const bf16x8 k1 = *(const LAS bf16x8*)(Kl + krow * 128 + (((4 + lq) ^ sw) << 4));
                    f32x4 z = {0.f, 0.f, 0.f, 0.f};
                    z = __builtin_amdgcn_mfma_f32_16x16x32_bf16(k0, qf[0], z, 0, 0, 0);
                    s[ff] = __builtin_amdgcn_mfma_f32_16x16x32_bf16(k1, qf[1], z, 0, 0, 0); }
                const int iq = 16 * a + lr; float m = sink2;
#pragma unroll
                for (int ff = 0; ff < 10; ++ff)
#pragma unroll
                    for (int e = 0; e < 4; ++e) { const int kp = 16 * (2 * p0 + ff) + 4 * lq + e; const bool ok = (kp > iq) && (kp <= iq + 128) && ((nb > 0) || (kp >= 128));
                        s[ff][e] = ok ? s[ff][e] : -1e30f; m = fmaxf(m, s[ff][e]); }
                m = fmaxf(m, __shfl_xor(m, 16)); m = fmaxf(m, __shfl_xor(m, 32));
                float sum = 0.f;
#pragma unroll
                for (int ff = 0; ff < 10; ++ff)
#pragma unroll
                    for (int e = 0; e < 4; ++e) { const float pv = exp2f(s[ff][e] - m); s[ff][e] = pv; sum += pv; }
                sum += __shfl_xor(sum, 16); sum += __shfl_xor(sum, 32);
                sum += exp2f(sink2 - m);
                const float inv = 1.0f / sum;
                f32x4 o[4];
#pragma unroll
                for (int df = 0; df < 4; ++df) o[df] = (f32x4){0.f, 0.f, 0.f, 0.f};
#pragma unroll
                for (int pr = 0; pr < 5; ++pr) {
                    u32x4 pw; pw.x = pk_bf16(s[2 * pr][0], s[2 * pr][1]); pw.y = pk_bf16(s[2 * pr][2], s[2 * pr][3]); pw.z = pk_bf16(s[2 * pr + 1][0], s[2 * pr + 1][1]); pw.w = pk_bf16(s[2 * pr + 1][2], s[2 * pr + 1][3]);
                    const bf16x8 pf = __builtin_bit_cast(bf16x8, pw);
                    const int key0 = 16 * (2 * p0 + 2 * pr) + 4 * lq;
#pragma unroll
                    for (int df = 0; df < 4; ++df) { const LAS unsigned char* vp = Vl + (16 * df + lr) * 528 + key0 * 2;
                        const u32x2 v0 = *(const LAS u32x2*)vp, v1 = *(const LAS u32x2*)(vp + 32);
                        u32x4 vw; vw.x = v0.x; vw.y = v0.y; vw.z = v1.x; vw.w = v1.y;
                        o[df] = __builtin_amdgcn_mfma_f32_16x16x32_bf16(__builtin_bit_cast(bf16x8, vw), pf, o[df], 0, 0, 0); }
                }
#pragma unroll
                for (int df = 0; df < 4; ++df) { u32x2 ov; ov.x = pk_bf16(o[df][0] * inv, o[df][1] * inv); ov.y = pk_bf16(o[df][2] * inv, o[df][3] * inv);
                    *(u32x2*)(att + (size_t)qrow * 1024 + hq * 64 + 16 * df + 4 * lq) = ov; }
            }
        }
        if (wk >= 0) {
            const int tlo = (T * xcd) / nxcd, thi = (T * (xcd + 1)) / nxcd;
            if (((thi - tlo) & 15) == 0) {
                const int nit = (thi - tlo) / 4;
#pragma unroll 1
                for (int it = wk * 8 + wid; it < nit; it += nwk * 8) { const int gi = it & 3, tok0 = tlo + ((it >> 2) * 2 + (lane >> 5)) * 8, ch = gi * 32 + (lane & 31);
                    if (gi == 0) pool_run<2>(proj, pg, tok0, ch); else if (gi == 1) pool_run<4>(proj, pg, tok0, ch); else if (gi == 2) pool_run<8>(proj, pg, tok0, ch); else pool_run<16>(proj, pg, tok0, ch); }
            } else {
            const int nitem = (thi - tlo) * 2;
#pragma unroll 1
            for (int it = wk * 8 + wid; it < nitem; it += nwk * 8) {
                const int gi = it & 3, tok = tlo + (it >> 2) * 2 + (lane >> 5), ch = gi * 32 + (lane & 31); const int tin = tok & (SEQ - 1);
                const int wl = 2 << gi; const int n = (tin + 1 < wl) ? tin + 1 : wl;
                float sacc[8];
#pragma unroll
                for (int e = 0; e < 8; ++e) sacc[e] = 0.f;
                const bf16_t* up = proj + (size_t)tok * INW + 1536 + ch * 8;
                const u32x4 u0 = *(const u32x4*)up;
                { u32x4 uv[16];
#pragma unroll
                    for (int k = 0; k < 16; ++k) { uv[k] = (u32x4){0u, 0u, 0u, 0u}; if (k < n) uv[k] = *(const u32x4*)(up - (size_t)k * INW); }
#pragma unroll
                    for (int k = 0; k < 16; ++k) { sacc[0] += bf_lo(uv[k].x); sacc[1] += bf_hi(uv[k].x); sacc[2] += bf_lo(uv[k].y); sacc[3] += bf_hi(uv[k].y); sacc[4] += bf_lo(uv[k].z); sacc[5] += bf_hi(uv[k].z); sacc[6] += bf_lo(uv[k].w); sacc[7] += bf_hi(uv[k].w); } }
                const float rn = 1.0f / (float)n;
                u32x4 ov; ov.x = pk_bf16(sacc[0] * rn - bf_lo(u0.x), sacc[1] * rn - bf_hi(u0.x)); ov.y = pk_bf16(sacc[2] * rn - bf_lo(u0.y), sacc[3] * rn - bf_hi(u0.y));
                ov.z = pk_bf16(sacc[4] * rn - bf_lo(u0.z), sacc[5] * rn - bf_hi(u0.z)); ov.w = pk_bf16(sacc[6] * rn - bf_lo(u0.w), sacc[7] * rn - bf_hi(u0.w));
                *(u32x4*)(pg + (size_t)tok * 1024 + ch * 8) = ov;
            } }
        }
        if (wk >= 0) {
            LAS int* tk = (LAS int*)(lds + LDS_TAB);
            for (;;) {
                __syncthreads();
                if (tid == 0) tk[0] = (int)atomicAdd(ctl + CTL_TICKET_OFF / 4 + 64, 1u);
                __syncthreads();
                const int tkt = __builtin_amdgcn_readfirstlane(tk[0]);
                if (tkt >= 32) break;
                { SchedWc S{wms, w_pool_branch, wc, tkt >> 3, (tkt & 7) * 256}; gemm_stream(lds, S); }
            }
        }
        if (wk >= 0) {
            LAS float* sc = (LAS float*)(lds + LDS_MAIN);
            LAS float* part = (LAS float*)(lds + LDS_MAIN + 16384);
            LAS int* tk = (LAS int*)(lds + LDS_TAB);
            __syncthreads();
            for (int i = tid; i < 4096; i += 512) { const float cv = cvec[i]; sc[i] = cv / (1.0f + __expf(-cv)); }
            for (;;) {
                __syncthreads();
                if (tid == 0) tk[0] = (int)atomicAdd(ctl + CTL_TICKET_OFF / 4, 1u);
                __syncthreads();
                const int cb = __builtin_amdgcn_readfirstlane(tk[0]);
                if (cb >= 171) break;
                const int j0 = 4096 + 48 * cb; const int ncol = (j0 + 48 <= 12288) ? 48 : 12288 - j0;
                if (tid < 504) {
                    const int q = tid % 12, kl = tid / 12;
                    f32x4 a0 = {0.f, 0.f, 0.f, 0.f}, a1 = {0.f, 0.f, 0.f, 0.f};
                    if (4 * q < ncol) { const float* wp = w_mod + j0 + 4 * q;
#pragma unroll 7
                        for (int k = kl; k < 2048; k += 42) { const f32x4 wv4 = *(const f32x4*)(wp + (size_t)k * 12288); a0 += wv4 * sc[k]; a1 += wv4 * sc[2048 + k]; } }
#pragma unroll
                    for (int e = 0; e < 4; ++e) { part[kl * 96 + q * 4 + e] = a0[e]; part[kl * 96 + 48 + q * 4 + e] = a1[e]; }
                }
                __syncthreads();
                if (tid < 96) { float s2 = 0.f; for (int kl = 0; kl < 42; ++kl) s2 += part[kl * 96 + tid]; const int b = tid / 48, jj = tid % 48; if (jj < ncol) modv[b * 12288 + j0 + jj] = s2 + b_mod[j0 + jj]; }
            }
        }
        __syncthreads();
    }
    SEAM(3);


    if (IN(5)) for (int rep_ = 0; rep_ < REPS(5); ++rep_) { PHASE_IDS();
        XCD_SETUP();
        const int ulo = (256 * xcd) / nxcd, uhi = (256 * (xcd + 1)) / nxcd;
        { int c = 0; for (int u = ulo + rnk; u < uhi; u += npx) ++c;
          SchedBranch S{att, pg, wba, wc, mrgf, mrg, proj, ulo + rnk, npx, c}; gemm_stream<SchedBranch, false, true>(lds, S); }
    }
    SEAM(5);

    if (IN(6)) for (int rep_ = 0; rep_ < REPS(6); ++rep_) { PHASE_IDS();
        XCD_SETUP();
        const int ulo = (256 * xcd) / nxcd, uhi = (256 * (xcd + 1)) / nxcd;
        { int c = 0; for (int u = ulo + rnk; u < uhi; u += npx) ++c;
          SchedOut S{mrg, wbo, mix, ulo + rnk, npx, c}; gemm_stream<SchedOut, false, true>(lds, S); }
    }
    SEAM(6);

    if (IN(7)) { PHASE_IDS();
        LAS unsigned char* h2s = lds + LDS_MAIN;
        LAS float* part = (LAS float*)(lds + LDS_MAIN);
        LAS float* lgt = (LAS float*)(lds + LDS_MAIN + 32768);
        LAS int* lcnt = (LAS int*)(lds + LDS_TAB);
        LAS int* sel = (LAS int*)(lds + LDS_TAB + 256);
        LAS float* selw = (LAS float*)(lds + LDS_TAB + 256 + 1024);
        for (int tile = blk; tile < T / 32; tile += gridDim.x) {
            __syncthreads();
            if (tid < 64) lcnt[tid] = 0;
            f32x4 cga[8], cgs[8];
            const float* mb = modv + ((tile * 32) >> 12) * 12288;
            const __amdgpu_buffer_rsrc_t r_gpm = mk_rsrc(g_post_mix, 8192u), r_gpf = mk_rsrc(g_pre_ffn, 8192u), r_mod = mk_rsrc(mb, 12288u * 4u);
            const unsigned lo16 = (unsigned)(lane * 16);
#pragma unroll
            for (int j = 0; j < 8; ++j) {
                cga[j] = __builtin_bit_cast(f32x4, __builtin_amdgcn_raw_buffer_load_b128(r_gpm, lo16, 1024 * j, 0)) * __builtin_bit_cast(f32x4, __builtin_amdgcn_raw_buffer_load_b128(r_mod, lo16, 2 * 8192 + 1024 * j, 0));
                cgs[j] = __builtin_bit_cast(f32x4, __builtin_amdgcn_raw_buffer_load_b128(r_gpf, lo16, 1024 * j, 0)) * (__builtin_bit_cast(f32x4, __builtin_amdgcn_raw_buffer_load_b128(r_mod, lo16, 4 * 8192 + 1024 * j, 0)) + 1.0f); }
#pragma unroll 1
            for (int rr = 0; rr < 4; ++rr) {
                const int rl = wid * 4 + rr; const int row = tile * 32 + rl;
                f32x4 mv[8], xw[8]; float ss = 0.f;
                u32x2 mw[8];
#pragma unroll
                for (int j = 0; j < 8; ++j) { mw[j] = *(const u32x2*)(mix + (size_t)row * D + 4 * lane + 256 * j); xw[j] = *(const f32x4*)(x + (size_t)row * D + 4 * lane + 256 * j); }
#pragma unroll
                for (int j = 0; j < 8; ++j) { mv[j] = (f32x4){bf_lo(mw[j].x), bf_hi(mw[j].x), bf_lo(mw[j].y), bf_hi(mw[j].y)}; ss += mv[j][0] * mv[j][0] + mv[j][1] * mv[j][1] + mv[j][2] * mv[j][2] + mv[j][3] * mv[j][3]; }
                ss = wave_sum(ss); const float r1 = rsqrtf(ss * (1.0f / D) + RMS_EPS);
                float ss2 = 0.f;
#pragma unroll
                for (int j = 0; j < 8; ++j) { const int col = 4 * lane + 256 * j;
                    const f32x4 x1 = xw[j] + cga[j] * (mv[j] * r1);
                    { u32x2 xo; xo.x = pk_bf16(x1[0], x1[1]); xo.y = pk_bf16(x1[2], x1[3]); *(u32x2*)(x1b + (size_t)row * D + col) = xo; } mv[j] = x1;
                    ss2 += x1[0] * x1[0] + x1[1] * x1[1] + x1[2] * x1[2] + x1[3] * x1[3]; }
                ss2 = wave_sum(ss2); const float r2 = rsqrtf(ss2 * (1.0f / D) + RMS_EPS);
#pragma unroll
                for (int j = 0; j < 8; ++j) { const int col = 4 * lane + 256 * j;
                    const f32x4 h = mv[j] * r2 * cgs[j] + __builtin_bit_cast(f32x4, __builtin_amdgcn_raw_buffer_load_b128(r_mod, lo16, 3 * 8192 + 1024 * j, 0));
                    u32x2 o; o.x = pk_bf16(h[0], h[1]); o.y = pk_bf16(h[2], h[3]);
                    *(u32x2*)(hbuf + (size_t)row * HS + col) = o; *(LAS u32x2*)(h2s + rl * 4112 + col * 2) = o; }
            }
            __syncthreads();
            f32x4 lacc[2][2];
#pragma unroll
            for (int mi = 0; mi < 2; ++mi)
#pragma unroll
                for (int ni = 0; ni < 2; ++ni) lacc[mi][ni] = (f32x4){0.f, 0.f, 0.f, 0.f};
#pragma unroll
            for (int ks = 0; ks < 8; ++ks) { const int k0 = 256 * wid + 32 * ks + 8 * (lane >> 4);
                bf16x8 af[2], bfv[2];
#pragma unroll
                for (int mi = 0; mi < 2; ++mi) af[mi] = *(const LAS bf16x8*)(h2s + (16 * mi + (lane & 15)) * 4112 + k0 * 2);
#pragma unroll
                for (int ni = 0; ni < 2; ++ni) bfv[ni] = *(const bf16x8*)(wrt + (16 * ni + (lane & 15)) * 2048 + k0);
#pragma unroll
                for (int mi = 0; mi < 2; ++mi)
#pragma unroll
                    for (int ni = 0; ni < 2; ++ni) lacc[mi][ni] = __builtin_amdgcn_mfma_f32_16x16x32_bf16(af[mi], bfv[ni], lacc[mi][ni], 0, 0, 0); }
            __syncthreads();
#pragma unroll
            for (int mi = 0; mi < 2; ++mi)
#pragma unroll
                for (int ni = 0; ni < 2; ++ni)
#pragma unroll
                    for (int e = 0; e < 4; ++e) part[(wid * 32 + 16 * mi + 4 * (lane >> 4) + e) * 32 + 16 * ni + (lane & 15)] = lacc[mi][ni][e];
            __syncthreads();
            for (int o = tid; o < 1024; o += 512) { const int r = o >> 5, e = o & 31; float s = b_router[e];
#pragma unroll
                for (int ww = 0; ww < 8; ++ww) s += part[(ww * 32 + r) * 32 + e];
                lgt[r * 33 + e] = s; }
            __syncthreads();
            if (tid < 32) {
                const int r = tid; float vals[4]; int idx[4]; unsigned used = 0u;
#pragma unroll
                for (int k = 0; k < 4; ++k) { float best = -3.0e38f; int bi = 0;
                    for (int e = 0; e < 32; ++e) { const float v = lgt[r * 33 + e]; if (!((used >> e) & 1u) && v > best) { best = v; bi = e; } }
                    used |= 1u << bi; vals[k] = best; idx[k] = bi; }
                float ex[4], se = 0.f;
#pragma unroll
                for (int k = 0; k < 4; ++k) { ex[k] = __expf(vals[k] - vals[0]); se += ex[k]; }
#pragma unroll
                for (int k = 0; k < 4; ++k) { sel[r * 4 + k] = idx[k]; sel[128 + r * 4 + k] = atomicAdd((int*)&lcnt[idx[k]], 1); selw[r * 4 + k] = ex[k] / se; }
            }
            __syncthreads();
            if (tid < 32) { const int c = lcnt[tid]; lcnt[32 + tid] = c ? (int)atomicAdd(&cntg[16 * tid], (unsigned)c) : 0; }
            __syncthreads();
            if (tid < 128) { const int r = tid >> 2; const int e = sel[tid]; const int pos = lcnt[32 + e] + sel[128 + tid]; const int tok = tile * 32 + r;
                ltok[e * T + pos] = tok; lw[e * T + pos] = selw[tid]; tslot[tok * 4 + (tid & 3)] = (e << 16) | pos; }
        }
        __syncthreads();
    }
    SEAM(7);

    if (IN(8)) for (int rep_ = 0; rep_ < REPS(8); ++rep_) { PHASE_IDS();
        moe_tables(lds, cntg);
        const LAS int* tab = (const LAS int*)(lds + LDS_TAB);
        XCD_SETUP();
        const int U = __builtin_amdgcn_readfirstlane(tab[96]) * 16; const int ulo = (U * xcd) / nxcd, uhi = (U * (xcd + 1)) / nxcd;
        { SchedGateUp S{lds, hbuf, ltok, w_gate_up, b_gate_up, act, ulo + rnk, npx, uhi}; gemm_stream<SchedGateUp, true>(lds, S); }
    }
    SEAM(8);

    if (IN(9)) for (int rep_ = 0; rep_ < REPS(9); ++rep_) { PHASE_IDS();
        moe_tables(lds, cntg);
        const LAS int* tab = (const LAS int*)(lds + LDS_TAB);
        XCD_SETUP();
        const int U = __builtin_amdgcn_readfirstlane(tab[96]) * 8; const int ulo = (U * xcd) / nxcd, uhi = (U * (xcd + 1)) / nxcd;
        const int chunk = uhi - ulo, full = chunk / npx, rem = chunk - full * npx; const bool split = (rem > 0) && (2 * rem <= npx);
        { int last = -1, lastkh = -1;
          if (rem > 0) { if (split) { if (rnk < 2 * rem) { last = ulo + full * npx + (rnk >> 1); lastkh = rnk & 1; } } else if (rnk < rem) last = ulo + full * npx + rnk; }
          SchedDown S{lds, act, lw, w_down, b_down, yb, yb2, sflag, ulo + rnk, npx, full, last, lastkh}; gemm_stream<SchedDown, true>(lds, S); }
    }
    SEAM(9);

    if (IN(10)) { PHASE_IDS();
        moe_tables(lds, cntg);
        const LAS int* tab = (const LAS int*)(lds + LDS_TAB);
        const int row0 = blk * 32 + wid * 4; const int b = row0 >> 12;
        f32x4 gg[8];
#pragma unroll
        for (int q = 0; q < 8; ++q) { const int col = 8 * lane + 512 * (q >> 1) + 4 * (q & 1); gg[q] = *(const f32x4*)(g_post_ffn + col) * *(const f32x4*)(modv + b * 12288 + 5 * 2048 + col); }
        int prow[4][4]; unsigned long long fl[4][4];
#pragma unroll
        for (int rr = 0; rr < 4; ++rr) { const i32x4 ts = *(const i32x4*)(tslot + (size_t)(row0 + rr) * 4);
#pragma unroll
            for (int k = 0; k < 4; ++k) prow[rr][k] = tab[64 + (ts[k] >> 16)] * 256 + (ts[k] & 0xffff); }
#pragma unroll
        for (int rr = 0; rr < 4; ++rr)
#pragma unroll
            for (int k = 0; k < 4; ++k) fl[rr][k] = *(const unsigned long long*)(sflag + (size_t)(prow[rr][k] >> 8) * 8);
        const __amdgpu_buffer_rsrc_t y2rs = mk_rsrc(yb2, (unsigned)((size_t)NPADROWS * D * 2));
#pragma unroll
        for (int rr = 0; rr < 4; ++rr) { const int row = row0 + rr;
            u32x4 x1w[4];
#pragma unroll
            for (int j = 0; j < 4; ++j) x1w[j] = *(const u32x4*)(x1b + (size_t)row * D + 8 * lane + 512 * j);
            float yv[4][8]; float ss = 0.f;
#pragma unroll
            for (int j = 0; j < 4; ++j) { const int col = 8 * lane + 512 * j; const int pnb = 8 * (2 * j + (lane >> 5));
                u32x4 v[4], v2[4];
#pragma unroll
                for (int k = 0; k < 4; ++k) { v[k] = *(const u32x4*)(yb + (size_t)prow[rr][k] * D + col);
                    const unsigned off2 = ((fl[rr][k] >> pnb) & 1ull) ? (unsigned)((prow[rr][k] * D + col) * 2) : 0xfffffff0u;
                    v2[k] = __builtin_bit_cast(u32x4, __builtin_amdgcn_raw_buffer_load_b128(y2rs, off2, 0, 0)); }
#pragma unroll
                for (int e = 0; e < 8; ++e) yv[j][e] = 0.f;
#pragma unroll
                for (int k = 0; k < 4; ++k) { yv[j][0] += bf_lo(v2[k].x); yv[j][1] += bf_hi(v2[k].x); yv[j][2] += bf_lo(v2[k].y); yv[j][3] += bf_hi(v2[k].y); yv[j][4] += bf_lo(v2[k].z); yv[j][5] += bf_hi(v2[k].z); yv[j][6] += bf_lo(v2[k].w); yv[j][7] += bf_hi(v2[k].w); }
#pragma unroll
                for (int k = 0; k < 4; ++k) { yv[j][0] += bf_lo(v[k].x); yv[j][1] += bf_hi(v[k].x); yv[j][2] += bf_lo(v[k].y); yv[j][3] += bf_hi(v[k].y); yv[j][4] += bf_lo(v[k].z); yv[j][5] += bf_hi(v[k].z); yv[j][6] += bf_lo(v[k].w); yv[j][7] += bf_hi(v[k].w); }
#pragma unroll
                for (int e = 0; e < 8; ++e) ss += yv[j][e] * yv[j][e]; }
            ss = wave_sum(ss); const float r = rsqrtf(ss * (1.0f / D) + RMS_EPS);
#pragma unroll
            for (int q = 0; q < 8; ++q) { const int col = 8 * lane + 512 * (q >> 1) + 4 * (q & 1);
                const f32x4 y = {yv[q >> 1][4 * (q & 1)], yv[q >> 1][4 * (q & 1) + 1], yv[q >> 1][4 * (q & 1) + 2], yv[q >> 1][4 * (q & 1) + 3]};
                const u32x4 xw_ = x1w[q >> 1]; const f32x4 x1 = (q & 1) ? (f32x4){bf_lo(xw_.z), bf_hi(xw_.z), bf_lo(xw_.w), bf_hi(xw_.w)} : (f32x4){bf_lo(xw_.x), bf_hi(xw_.x), bf_lo(xw_.y), bf_hi(xw_.y)};
                *(f32x4*)(out + (size_t)row * D + col) = x1 + gg[q] * (y * r); }
        }
    }

#undef IN
#undef SEAM
}

extern "C" void kernel_launch(void* const* d_in, const int* in_sizes, int n_in, void* d_out, int out_size, void* d_ws, size_t ws_size, hipStream_t stream) {
    static int grid = 0;
    if (grid == 0) {
        if (n_in != 22 || out_size != T * D || ws_size < WS_END) { fprintf(stderr, "kernel_launch: unexpected shapes (n_in %d out %d ws %zu need %zu)\n", n_in, out_size, ws_size, (size_t)WS_END); grid = -1; return; }
        int dev = 0, cus = 0, per_cu = 0;
        if (hipGetDevice(&dev) != hipSuccess || hipDeviceGetAttribute(&cus, hipDeviceAttributeMultiprocessorCount, dev) != hipSuccess) { grid = -1; return; }
        if (hipFuncSetAttribute((const void*)mk_fwd, hipFuncAttributeMaxDynamicSharedMemorySize, LDS_BYTES) != hipSuccess) { fprintf(stderr, "kernel_launch: hipFuncSetAttribute failed\n"); grid = -1; return; }
        if (hipOccupancyMaxActiveBlocksPerMultiprocessor(&per_cu, (const void*)mk_fwd, 512, LDS_BYTES) != hipSuccess || per_cu < 1) fprintf(stderr, "kernel_launch: occupancy query says %d\n", per_cu);
        (void)hipGetLastError();
        grid = cus;
    }
    if (grid < 0) return;
    (void)hipMemsetAsync((char*)d_ws + WS_CTL, 0, CTL_BYTES, stream);
    Args a{};
    for (int i = 0; i < 22; ++i) a.in[i] = (const float*)d_in[i];
    a.out = (float*)d_out; a.ws = (unsigned char*)d_ws;
    if (MK_N_LAUNCHES == 1) {
        a.ph_lo = 0; a.ph_hi = NPHASE;
        hipLaunchKernelGGL(mk_fwd, dim3(grid), dim3(512), LDS_BYTES, stream, a);
    } else {
        for (int p = 0; p < NPHASE; ++p) { a.ph_lo = p; a.ph_hi = p + 1; hipLaunchKernelGGL(mk_fwd, dim3(grid), dim3(512), LDS_BYTES, stream, a); }
    }
    const hipError_t le = hipPeekAtLastError();
    if (le != hipSuccess) fprintf(stderr, "kernel_launch: launch failed: %s\n", hipGetErrorName(le));
}
```

```cpp
#include <hip/hip_runtime.h>
#include <hip/hip_bf16.h>
#include <cstdio>
#include <cstdint>

#ifndef MK_N_LAUNCHES
#define MK_N_LAUNCHES 1
#endif

constexpr int T = 8192, D = 2048, SEQ = 4096, INW = 6656, NE = 32, DFF = 2048;
constexpr int NPHASE = 11;
constexpr int HS = 2048 + 64;
constexpr float RMS_EPS = 1e-6f;
constexpr float LOG2E = 1.4426950408889634f;

#define LAS __attribute__((address_space(3)))
typedef unsigned short bf16_t;
typedef short bf16x8 __attribute__((ext_vector_type(8)));
typedef float f32x4 __attribute__((ext_vector_type(4)));
typedef float f32x2 __attribute__((ext_vector_type(2)));
typedef unsigned u32x4 __attribute__((ext_vector_type(4)));
typedef unsigned u32x2 __attribute__((ext_vector_type(2)));
typedef __bf16 bf16x2_t __attribute__((ext_vector_type(2)));

#define XB_TMO      128
#define XB_XCNT(j)  (256  + 64 * (j))
#define XB_XSUB(j)  (1280 + 64 * (j))
#define XB_XGEN(j)  (2304 + 64 * (j))
#define XB_TOP      3328
#define XB_TOPGEN   3392
#define XCD_BAR_WORDS 3456
#define XB_SPIN_CAP (1u << 18)

__device__ __forceinline__ unsigned xb_ld(unsigned* p)              { return __hip_atomic_load(p, __ATOMIC_RELAXED, __HIP_MEMORY_SCOPE_AGENT); }
__device__ __forceinline__ unsigned xb_add(unsigned* p, unsigned v) { return __hip_atomic_fetch_add(p, v, __ATOMIC_RELAXED, __HIP_MEMORY_SCOPE_AGENT); }
__device__ __forceinline__ unsigned xb_xcc_id() { return (unsigned)__builtin_amdgcn_s_getreg((3 << 11) | 20) & 0xFu; }
#define XB_SPIN(cond, bar) do { unsigned _sp = 0; while (cond) { __builtin_amdgcn_s_sleep(1); \
    if ((++_sp & 255u) == 0u) { if (xb_ld(&(bar)[XB_TMO])) break; if (_sp > XB_SPIN_CAP) { atomicAdd(&(bar)[XB_TMO], 1u); break; } } } } while (0)

struct XcdBarrier { unsigned* bar; unsigned x; volatile LAS unsigned* st; };

__device__ __forceinline__ XcdBarrier xcd_barrier_post(unsigned* bar, volatile LAS unsigned* st) {
    XcdBarrier b; b.bar = bar; b.x = xb_xcc_id(); b.st = st;
    if (threadIdx.x == 0) (void)xb_add(&bar[XB_XCNT(b.x)], 1u);
    return b;
}
__device__ __forceinline__ void xcd_barrier_complete(unsigned* bar, unsigned x, unsigned& nloc, unsigned& nx) {
    const unsigned G = gridDim.x * gridDim.y * gridDim.z;
    unsigned sum, cnt, mine, sp = 0u;
    for (;;) {
        sum = 0u; cnt = 0u; mine = 0u;
#pragma unroll
        for (unsigned j = 0; j < 16; ++j) { const unsigned c = xb_ld(&bar[XB_XCNT(j)]); sum += c; cnt += (c > 0u) ? 1u : 0u; mine = (j == x) ? c : mine; }
        if (sum == G) break;
        __builtin_amdgcn_s_sleep(1);
        if ((++sp & 255u) == 0u) { if (xb_ld(&bar[XB_TMO])) break; if (sp > XB_SPIN_CAP) { atomicAdd(&bar[XB_TMO], 1u); break; } }
    }
    nloc = mine > 0u ? mine : 1u; nx = cnt > 0u ? cnt : 1u;
}
__device__ __forceinline__ void xcd_barrier(const XcdBarrier& b) {
    asm volatile("s_waitcnt vmcnt(0)" ::: "memory");
    __syncthreads();
    if (threadIdx.x == 0) {
        unsigned* bar = b.bar;
        __builtin_amdgcn_s_waitcnt(0);
        unsigned nloc = b.st[0], nx = b.st[1];
        if (nloc == 0u) { xcd_barrier_complete(bar, b.x, nloc, nx); b.st[0] = nloc; b.st[1] = nx; }
        const unsigned old = xb_add(&bar[XB_XSUB(b.x)], 1u);
        const unsigned gen = old / nloc;
        if (old + 1u == (gen + 1u) * nloc) {
            __builtin_amdgcn_fence(__ATOMIC_RELEASE, "agent");
            asm volatile("s_waitcnt vmcnt(0)" ::: "memory");
            const unsigned og = xb_add(&bar[XB_TOP], 1u);
            const unsigned tg = og / nx;
            if (og + 1u == (tg + 1u) * nx) xb_add(&bar[XB_TOPGEN], 1u);
            else XB_SPIN(xb_ld(&bar[XB_TOPGEN]) == tg, bar);
            __builtin_amdgcn_fence(__ATOMIC_ACQUIRE, "agent");
            xb_add(&bar[XB_XGEN(b.x)], 1u);
            asm volatile("s_waitcnt vmcnt(0)" ::: "memory");
        } else {
            XB_SPIN(xb_ld(&bar[XB_XGEN(b.x)]) == gen, bar);
            __builtin_amdgcn_fence(__ATOMIC_ACQUIRE, "agent");
            asm volatile("s_waitcnt vmcnt(0)" ::: "memory");
        }
    }
    __syncthreads();
}

constexpr size_t al256(size_t x) { return (x + 255) & ~(size_t)255; }
constexpr size_t WS_CTL   = 0;
constexpr size_t CTL_BYTES = 65536;
constexpr size_t CTL_CNT_OFF = 16384;
constexpr size_t CTL_RANK_OFF = 32768;
constexpr size_t CTL_TICKET_OFF = 49152;
constexpr size_t CTL_FLAG_OFF = 53248;
constexpr size_t WS_MOD   = WS_CTL + CTL_BYTES;
constexpr size_t WS_WRT   = al256(WS_MOD + 2 * 12288 * 4);
constexpr size_t WS_WMS   = al256(WS_WRT + 32 * 2048 * 2);
constexpr size_t WS_H     = al256(WS_WMS + 4 * 256 * 256 * 2);
constexpr size_t WS_PROJ  = al256(WS_H + (size_t)T * HS * 2);
constexpr size_t WS_VT    = al256(WS_PROJ + (size_t)T * INW * 2);
constexpr size_t WS_ATT   = al256(WS_VT + (size_t)2 * 4 * 64 * SEQ * 2);
constexpr size_t WS_PG    = al256(WS_ATT + (size_t)T * 1024 * 2);
constexpr size_t WS_PP    = al256(WS_PG + (size_t)T * 1024 * 2);
constexpr size_t WS_MRGF  = al256(WS_PP + (size_t)T * 1024 * 2);
constexpr size_t WS_MRG   = al256(WS_MRGF + (size_t)T * D * 4);
constexpr size_t WS_MIX   = al256(WS_MRG + (size_t)T * D * 2);
constexpr size_t WS_LTOK  = al256(WS_MIX + (size_t)T * D * 4);
constexpr size_t WS_LW    = al256(WS_LTOK + (size_t)NE * T * 4);
constexpr size_t WS_TSLOT = al256(WS_LW + (size_t)NE * T * 4);
constexpr int    NPADROWS = T * 4 + NE * 256;
constexpr size_t WS_ACT   = al256(WS_TSLOT + (size_t)T * 4 * 4);
constexpr size_t WS_YB    = al256(WS_ACT + (size_t)NPADROWS * DFF * 2);
constexpr size_t WS_YB2   = al256(WS_YB + (size_t)NPADROWS * D * 2);
constexpr size_t WS_WBIN  = al256(WS_YB2 + (size_t)NPADROWS * D * 2);
constexpr size_t WS_WBA   = al256(WS_WBIN + (size_t)D * INW * 2);
constexpr size_t WS_WBO   = al256(WS_WBA + (size_t)1024 * D * 2);
constexpr size_t WS_END   = al256(WS_WBO + (size_t)D * D * 2);

constexpr int LDS_BAR  = 0;
constexpr int LDS_MAIN = 1024;
constexpr int LDS_A0 = LDS_MAIN, LDS_B0 = LDS_MAIN + 65536;
constexpr int LDS_TAB  = LDS_MAIN + 132096;
constexpr int LDS_BYTES = LDS_TAB + 4096;

struct Args {
    const float* in[22];
    float* out;
    unsigned char* ws;
    int ph_lo, ph_hi;
};

__device__ __forceinline__ unsigned pk_bf16(float lo, float hi) { f32x2 v = {lo, hi}; bf16x2_t b = __builtin_convertvector(v, bf16x2_t); return __builtin_bit_cast(unsigned, b); }
__device__ __forceinline__ float bf_lo(unsigned u) { return __uint_as_float(u << 16); }
__device__ __forceinline__ float bf_hi(unsigned u) { return __uint_as_float(u & 0xffff0000u); }
__device__ __forceinline__ float wave_sum(float v) {
#pragma unroll
    for (int o = 32; o >= 1; o >>= 1) v += __shfl_xor(v, o);
    return v;
}
__device__ __forceinline__ int swz(int r) { return (((r >> 1) ^ (r >> 4)) & 1) | (((r >> 2) & 1) << 1) | ((((r >> 3) ^ (r >> 5)) & 1) << 2); }

struct Wv { int tid, wid, lane, wm, wn, lr, lq; unsigned offA0, offB0, bw0, aw0; };

__device__ __forceinline__ void wv_init(Wv& w, int perm = 0) {
    w.tid = threadIdx.x; asm volatile("" : "+v"(w.tid));
    w.lane = w.tid & 63; w.wid = __builtin_amdgcn_readfirstlane(w.tid >> 6);
    w.wm = w.wid >> 2; w.wn = w.wid & 3; w.lr = w.lane & 15; w.lq = w.lane >> 4;
    const int v = w.lq ^ (w.lr >> 1);
    w.offA0 = (unsigned)((w.wm * 128 + w.lr) * 128 + (v << 4));
    w.offB0 = (unsigned)((w.wn * 64 + w.lr) * 128 + (v << 4));
    const int l = w.lane; const int rho = perm ? 64 * (l >> 4) + 32 * ((l >> 3) & 1) + 16 * (l & 1) + 4 * ((l >> 1) & 3) : 64 * (l >> 4) + 16 * (l & 3) + 4 * ((l >> 2) & 3);
    w.bw0 = (unsigned)(rho * 128 + ((w.wid ^ swz(rho)) << 4));
    { const int r0 = w.wid * 8 + (l >> 3); w.aw0 = (unsigned)(r0 * 128 + (((l & 7) ^ swz(r0)) << 4)); }
}
__device__ __forceinline__ int dma_row(const Wv& w, int p) { return p * 64 + w.wid * 8 + (w.lane >> 3); }
__device__ __forceinline__ int dma_chunk(const Wv& w, int p) { (void)p; return (w.lane & 7); }

#define KAPX(i, ks) (((((ks) << 2) ^ (((i) & 1) | (((i) & 2) << 1)))) << 4)

typedef int i32x4 __attribute__((ext_vector_type(4)));
__device__ __forceinline__ i32x4 mk_desc(const void* p, unsigned bytes) { const unsigned long long a = (unsigned long long)p; i32x4 d; d.x = __builtin_amdgcn_readfirstlane((int)(unsigned)a); d.y = __builtin_amdgcn_readfirstlane((int)((unsigned)(a >> 32) & 0xffffu)); d.z = __builtin_amdgcn_readfirstlane((int)bytes); d.w = 0x00020000; return d; }
__device__ __forceinline__ __amdgpu_buffer_rsrc_t mk_rsrc(const void* p, unsigned bytes) { return __builtin_amdgcn_make_buffer_rsrc((void*)p, (short)0, (int)bytes, 0x00020000); }

struct LoadDesc {
    const void* Ap; unsigned Abytes; unsigned arow[4]; int apitch64;
    const void* Wp; unsigned Wbytes; unsigned bvoff; int ldwb;
    int nkt;
    int nvalid;
};
template <class Sched, bool GATHER = false, bool WBF16 = false>
__device__ __forceinline__ void gemm_stream(LAS unsigned char* lds, const Sched& S) {
    typedef typename Sched::Epi Epi;
    Wv w; wv_init(w, Epi::PERM);
    LoadDesc cur, nxt; Epi ecur, enxt;
    if (!S.next(0, w, cur, ecur)) return;
    int ui = 1; bool has_nxt = S.next(1, w, nxt, enxt);
    f32x4 acc[8][4];
    f32x4 breg[WBF16 ? 1 : 8]; u32x2 bhr[WBF16 ? 8 : 1];
    u32x4 areg[4];
    bf16x8 afr[8], bfr[4];
    const int half = w.wm;
#define G_BAR() asm volatile("s_barrier" ::: "memory")
#define G_LGKM0() asm volatile("s_waitcnt lgkmcnt(0)" ::: "memory")
#define G_LDSEL(t2) const bool sel_ = ((t2) >= cur.nkt) && has_nxt; const int kt_ = ((t2) >= cur.nkt) ? (t2) - cur.nkt : (t2);
#define G_LDA(t2, h) do { G_LDSEL(t2) \
        const __amdgpu_buffer_rsrc_t ars_ = mk_rsrc(sel_ ? nxt.Ap : cur.Ap, sel_ ? nxt.Abytes : cur.Abytes); const int ap64_ = sel_ ? nxt.apitch64 : cur.apitch64; (void)ap64_; \
        _Pragma("unroll") for (int q = 0; q < 2; ++q) { const int p = 2 * (h) + q; const unsigned av_ = GATHER ? (sel_ ? nxt.arow[p] : cur.arow[p]) : (sel_ ? nxt.arow[0] : cur.arow[0]); \
            areg[p] = __builtin_bit_cast(u32x4, __builtin_amdgcn_raw_buffer_load_b128(ars_, av_, GATHER ? kt_ * 128 : kt_ * 128 + p * ap64_, 0)); } } while (0)
#define G_LDA1(t2, h, q) do { G_LDSEL(t2) \
        const __amdgpu_buffer_rsrc_t ars_ = mk_rsrc(sel_ ? nxt.Ap : cur.Ap, sel_ ? nxt.Abytes : cur.Abytes); const int ap64_ = sel_ ? nxt.apitch64 : cur.apitch64; (void)ap64_; \
        { const int p = 2 * (h) + (q); const unsigned av_ = GATHER ? (sel_ ? nxt.arow[p] : cur.arow[p]) : (sel_ ? nxt.arow[0] : cur.arow[0]); \
            areg[p] = __builtin_bit_cast(u32x4, __builtin_amdgcn_raw_buffer_load_b128(ars_, av_, GATHER ? kt_ * 128 : kt_ * 128 + p * ap64_, 0)); } } while (0)
#define G_LDB(t2, h, j0, j1) do { G_LDSEL(t2) \
        const __amdgpu_buffer_rsrc_t wrs_ = mk_rsrc(sel_ ? nxt.Wp : cur.Wp, sel_ ? nxt.Wbytes : cur.Wbytes); const int ldwb_ = sel_ ? nxt.ldwb : cur.ldwb; const unsigned bvo_ = sel_ ? nxt.bvoff : cur.bvoff; \
        _Pragma("unroll") for (int j = (j0); j < (j1); ++j) { if constexpr (WBF16) bhr[4 * (h) + j] = __builtin_bit_cast(u32x2, __builtin_amdgcn_raw_buffer_load_b64(wrs_, bvo_, (kt_ * 64 + 4 * (h) + j) * ldwb_, 0)); \
            else breg[4 * (h) + j] = __builtin_bit_cast(f32x4, __builtin_amdgcn_raw_buffer_load_b128(wrs_, bvo_, (kt_ * 64 + 4 * (h) + j) * ldwb_, 0)); } } while (0)
#define G_LD(t2, h) do { G_LDA(t2, h); G_LDB(t2, h, 0, 4); } while (0)
#define G_FENCE() asm volatile("" ::: "memory")
#define G_AWR(buf, h) do { _Pragma("unroll") for (int q = 0; q < 2; ++q) { const int p = 2 * (h) + q; \
        *(LAS u32x4*)(lds + LDS_A0 + (buf) * 32768 + w.aw0 + p * 8192) = areg[p]; } } while (0)
#define G_BWR(buf, h) do { _Pragma("unroll") for (int c = 0; c < 4; ++c) { u32x2 v_; \
        if constexpr (WBF16) { const unsigned sl_ = (c & 1) ? 0x07060302u : 0x05040100u; \
            v_.x = __builtin_amdgcn_perm(bhr[4 * (h) + 1][c >> 1], bhr[4 * (h)][c >> 1], sl_); v_.y = __builtin_amdgcn_perm(bhr[4 * (h) + 3][c >> 1], bhr[4 * (h) + 2][c >> 1], sl_); } \
        else { v_.x = pk_bf16(breg[WBF16 ? 0 : 4 * (h)][c], breg[WBF16 ? 0 : 4 * (h) + 1][c]); v_.y = pk_bf16(breg[WBF16 ? 0 : 4 * (h) + 2][c], breg[WBF16 ? 0 : 4 * (h) + 3][c]); } \
        *(LAS u32x2*)(lds + LDS_B0 + (buf) * 32768 + (w.bw0 ^ ((c >> 1) << 4)) + c * 128 + 8 * (h)) = v_; } } while (0)
#define G_FRAGB(buf, ks) do { \
        _Pragma("unroll") for (int j = 0; j < 4; ++j) bfr[j] = *(const LAS bf16x8*)(lds + LDS_B0 + (buf) * 32768 + (w.offB0 ^ KAPX(j, ks)) + j * 2048); } while (0)
#define G_FRAGA(buf, ks) do { \
        _Pragma("unroll") for (int i = 0; i < 8; ++i) afr[i] = *(const LAS bf16x8*)(lds + LDS_A0 + (buf) * 32768 + (w.offA0 ^ KAPX(i, ks)) + i * 2048); } while (0)
#define G_MMAR(i0, i1) do { if (ni) { _Pragma("unroll") for (int i = (i0); i < (i1); ++i) _Pragma("unroll") for (int j = 0; j < 4; ++j) \
        asm volatile("v_mfma_f32_16x16x32_bf16 %0, %1, %2, %0" : "+v"(acc[i][j]) : "v"(bfr[j]), "v"(afr[i])); } } while (0)
#define G_MMA0R(i0, i1) do { if (ni) { _Pragma("unroll") for (int i = (i0); i < (i1); ++i) _Pragma("unroll") for (int j = 0; j < 4; ++j) \
        asm volatile("v_mfma_f32_16x16x32_bf16 %0, %1, %2, 0" : "=v"(acc[i][j]) : "v"(bfr[j]), "v"(afr[i])); } } while (0)
#define G_MSEG(MM, t2, h) do { MM(0, 1); G_FENCE(); G_LDA1(t2, h, 0); G_FENCE(); MM(1, 2); G_FENCE(); G_LDA1(t2, h, 1); G_FENCE(); MM(2, 3); G_FENCE(); G_LDB(t2, h, 0, 1); G_FENCE(); MM(3, 4); G_FENCE(); G_LDB(t2, h, 1, 2); G_FENCE(); MM(4, 5); G_FENCE(); G_LDB(t2, h, 2, 3); G_FENCE(); MM(5, 6); G_FENCE(); G_LDB(t2, h, 3, 4); G_FENCE(); MM(6, 8); } while (0)
#define G_TILE0() do { \
          G_FRAGB(0, 0); G_AWR(1, 0); G_BWR(1, 0); G_FRAGA(0, 0); G_LGKM0(); G_BAR(); \
          G_MSEG(G_MMA0R, 2, 0); G_BAR(); \
          G_FRAGB(0, 1); G_AWR(1, 1); G_BWR(1, 1); G_FRAGA(0, 1); G_LGKM0(); G_BAR(); \
          G_MSEG(G_MMAR, 2, 1); G_BAR(); } while (0)
#define G_TILE(t, b) do { \
          G_FRAGB(b, 0); G_AWR((b) ^ 1, 0); G_BWR((b) ^ 1, 0); G_FRAGA(b, 0); G_LGKM0(); G_BAR(); \
          G_MSEG(G_MMAR, (t) + 2, 0); G_BAR(); \
          G_FRAGB(b, 1); G_AWR((b) ^ 1, 1); G_BWR((b) ^ 1, 1); G_FRAGA(b, 1); G_LGKM0(); G_BAR(); \
          G_MSEG(G_MMAR, (t) + 2, 1); G_BAR(); } while (0)
#define G_TILEX(t, b, skip) do { \
          G_FRAGB(b, 0); G_AWR((b) ^ 1, 0); G_BWR((b) ^ 1, 0); G_FRAGA(b, 0); G_LGKM0(); G_BAR(); \
          G_MSEG(G_MMAR, (t) + 2, 0); G_BAR(); \
          G_FRAGB(b, 1); G_AWR((b) ^ 1, 1); G_BWR((b) ^ 1, 1); G_FRAGA(b, 1); G_LGKM0(); G_BAR(); \
          G_MSEG(G_MMAR, (t) + 2, 1); if (!(skip)) G_BAR(); } while (0)

    G_LD(0, 0); G_LD(0, 1);
    G_AWR(0, 0); G_AWR(0, 1); G_BWR(0, 0); G_BWR(0, 1);
    G_LD(1, 0); G_LD(1, 1);
    G_LGKM0(); G_BAR();
    if (half == 1) G_BAR();
#pragma unroll 1
    for (;;) {
        int ni = 1; if constexpr (Sched::ROWSKIP) ni = __builtin_amdgcn_readfirstlane((cur.nvalid > half * 128) ? 1 : 0);
        G_TILE0(); G_TILE(1, 1);
#pragma unroll 1
        for (int t = 2; t < cur.nkt; t += 2) { G_TILE(t, 0); G_TILEX(t + 1, 1, (half == 1) && (t + 2 >= cur.nkt)); }
        asm volatile("s_nop 15\n\ts_nop 15\n\ts_nop 15" ::: "memory");
        ecur(acc, w);
        if (!has_nxt) break;
        cur = nxt; ecur = enxt; ++ui; has_nxt = S.next(ui, w, nxt, enxt);
        if (half == 1) G_BAR();
    }
    asm volatile("s_setprio 0");
    __syncthreads();
#undef G_BAR
#undef G_LGKM0
#undef G_LD
#undef G_AWR
#undef G_BWR
#undef G_FRAGB
#undef G_FRAGA
#undef G_MMAR
#undef G_MMA0R
#undef G_MSEG
#undef G_LDA
#undef G_LDA1
#undef G_LDB
#undef G_LDSEL
#undef G_FENCE
#undef G_TILE0
#undef G_TILE
#undef G_TILEX
}

struct LaneXY { int lr, lq, wm, wn; };
__device__ __forceinline__ LaneXY opaque_xy(const Wv& w) { LaneXY q; int l = w.lane; asm volatile("" : "+v"(l)); q.lr = l & 15; q.lq = l >> 4; q.wm = w.wm; q.wn = w.wn; return q; }
#define PCOL(j, lq) (32 * ((j) >> 1) + 8 * (lq) + 4 * ((j) & 1))
__device__ __forceinline__ void st_row_bf16(bf16_t* rowp  , int lq, const f32x4& a0, const f32x4& a1, const f32x4& a2, const f32x4& a3) {
    u32x4 o0, o1; o0.x = pk_bf16(a0[0], a0[1]); o0.y = pk_bf16(a0[2], a0[3]); o0.z = pk_bf16(a1[0], a1[1]); o0.w = pk_bf16(a1[2], a1[3]);
    o1.x = pk_bf16(a2[0], a2[1]); o1.y = pk_bf16(a2[2], a2[3]); o1.z = pk_bf16(a3[0], a3[1]); o1.w = pk_bf16(a3[2], a3[3]);
    *(u32x4*)(rowp + 8 * lq) = o0; *(u32x4*)(rowp + 32 + 8 * lq) = o1;
}
struct EpiProj {
    static constexpr int PERM = 1;
    bf16_t* proj; bf16_t* vt; const float* bias; int m0, n0;
    __device__ __forceinline__ void operator()(f32x4 (&acc)[8][4], const Wv& w0) const { const LaneXY w = opaque_xy(w0);
        const int colw = n0 + w.wn * 64;
        f32x4 bv[4];
#pragma unroll
        for (int j = 0; j < 4; ++j) bv[j] = *(const f32x4*)(bias + colw + PCOL(j, w.lq));
        if (n0 == 1280) {
#pragma unroll
            for (int i = 0; i < 8; ++i) { const int row = m0 + w.wm * 128 + i * 16 + w.lr; const int b = row >> 12, sq = row & 4095;
#pragma unroll
                for (int j = 0; j < 4; ++j)
#pragma unroll
                    for (int e = 0; e < 4; ++e) { const int d = PCOL(j, w.lq) + e; const float v = acc[i][j][e] + bv[j][e];
                        vt[((size_t)((b * 4 + w.wn) * 64 + d)) * SEQ + sq] = (bf16_t)(pk_bf16(v, 0.f) & 0xffffu); } }
            return;
        }
        const float qs = (n0 < 1024) ? 0.125f * LOG2E : 1.0f;
        const bool sig = n0 >= 2560;
#pragma unroll
        for (int i = 0; i < 8; ++i) { const int row = m0 + w.wm * 128 + i * 16 + w.lr;
            f32x4 v[4];
#pragma unroll
            for (int j = 0; j < 4; ++j)
#pragma unroll
                for (int e = 0; e < 4; ++e) { float x = (acc[i][j][e] + bv[j][e]) * qs; if (sig) x = __builtin_amdgcn_rcpf(1.0f + __builtin_amdgcn_exp2f(-LOG2E * x)); v[j][e] = x; }
            st_row_bf16(proj + (size_t)row * INW + colw, w.lq, v[0], v[1], v[2], v[3]); }
    }
};
struct EpiWc {
    static constexpr int PERM = 1;
    bf16_t* wc; int r0, n0;
    __device__ __forceinline__ void operator()(f32x4 (&acc)[8][4], const Wv& w0) const { const LaneXY w = opaque_xy(w0);
        const int colw = n0 + w.wn * 64;
#pragma unroll
        for (int i = 0; i < 8; ++i) { const int row = r0 + w.wm * 128 + i * 16 + w.lr; st_row_bf16(wc + (size_t)row * D + colw, w.lq, acc[i][0], acc[i][1], acc[i][2], acc[i][3]); }
    }
};
struct EpiBranch {
    static constexpr int PERM = 1;
    bf16_t* part; bf16_t* mrg; const bf16_t* proj; int m0, n0, second;
    __device__ __forceinline__ void operator()(f32x4 (&acc)[8][4], const Wv& w0) const { const LaneXY w = opaque_xy(w0);
        const int colw = n0 + w.wn * 64;
        if (second) asm volatile("s_waitcnt vmcnt(0)" ::: "memory");
#pragma unroll
        for (int i = 0; i < 8; ++i) { const int row = m0 + w.wm * 128 + i * 16 + w.lr;
            const bf16_t* gp = proj + (size_t)row * INW + 2560 + second * 2048 + colw;
            const u32x4 g0 = *(const u32x4*)(gp + 8 * w.lq), g1 = *(const u32x4*)(gp + 32 + 8 * w.lq);
            const unsigned gw[8] = {g0.x, g0.y, g0.z, g0.w, g1.x, g1.y, g1.z, g1.w};
            f32x4 r[4];
#pragma unroll
            for (int j = 0; j < 4; ++j) { f32x4 g = {bf_lo(gw[2 * j]), bf_hi(gw[2 * j]), bf_lo(gw[2 * j + 1]), bf_hi(gw[2 * j + 1])}; r[j] = acc[i][j] * g; }
            bf16_t* pp_ = part + (size_t)row * D + colw;
            if (second == 0) { st_row_bf16(pp_, w.lq, r[0], r[1], r[2], r[3]); }
            else {
                const u32x4 p0 = *(const u32x4*)(pp_ + 8 * w.lq), p1 = *(const u32x4*)(pp_ + 32 + 8 * w.lq);
                const unsigned pw[8] = {p0.x, p0.y, p0.z, p0.w, p1.x, p1.y, p1.z, p1.w};
#pragma unroll
                for (int j = 0; j < 4; ++j) { r[j][0] += bf_lo(pw[2 * j]); r[j][1] += bf_hi(pw[2 * j]); r[j][2] += bf_lo(pw[2 * j + 1]); r[j][3] += bf_hi(pw[2 * j + 1]); }
                st_row_bf16(mrg + (size_t)row * D + colw, w.lq, r[0], r[1], r[2], r[3]);
            } }
    }
};
struct EpiOut {
    static constexpr int PERM = 1;
    bf16_t* mix; int m0, n0;
    __device__ __forceinline__ void operator()(f32x4 (&acc)[8][4], const Wv& w0) const { const LaneXY w = opaque_xy(w0);
        const int colw = n0 + w.wn * 64;
#pragma unroll
        for (int i = 0; i < 8; ++i) { const int row = m0 + w.wm * 128 + i * 16 + w.lr; st_row_bf16(mix + (size_t)row * D + colw, w.lq, acc[i][0], acc[i][1], acc[i][2], acc[i][3]); }
    }
};
struct EpiSwiglu {
    static constexpr int PERM = 0;
    bf16_t* act; const float* bias; int orow0, n0, nv;
    __device__ __forceinline__ void operator()(f32x4 (&acc)[8][4], const Wv& w0) const { const LaneXY w = opaque_xy(w0);
        const int colb = n0 + w.wn * 64 + 16 * w.lq;
        constexpr float SC = 1.702f * LOG2E, RSC = 1.0f / SC;
        f32x4 bv[4];
#pragma unroll
        for (int j = 0; j < 4; ++j) { bv[j] = *(const f32x4*)(bias + colb + 4 * j); bv[j][0] *= SC; bv[j][2] *= SC; bv[j][1] = (bv[j][1] + 1.0f) * RSC; bv[j][3] = (bv[j][3] + 1.0f) * RSC; }
#pragma unroll
        for (int i = 0; i < 8; ++i) { const int row = orow0 + w.wm * 128 + i * 16 + w.lr;
            float o[8];
#pragma unroll
            for (int j = 0; j < 4; ++j)
#pragma unroll
                for (int h = 0; h < 2; ++h) { const float t = fminf(__builtin_fmaf(acc[i][j][2 * h], SC, bv[j][2 * h]), 7.0f * SC);
                    const float m = __builtin_amdgcn_fmed3f(__builtin_fmaf(acc[i][j][2 * h + 1], RSC, bv[j][2 * h + 1]), -6.0f * RSC, 8.0f * RSC);
                    o[2 * j + h] = t * __builtin_amdgcn_rcpf(1.0f + __builtin_amdgcn_exp2f(-t)) * m; }
            u32x4 ov; ov.x = pk_bf16(o[0], o[1]); ov.y = pk_bf16(o[2], o[3]); ov.z = pk_bf16(o[4], o[5]); ov.w = pk_bf16(o[6], o[7]);
            if (w.wm * 128 + i * 16 + w.lr < nv) *(u32x4*)(act + (size_t)row * DFF + (colb >> 1)) = ov; }
    }
};
struct EpiDown {
    static constexpr int PERM = 1;
    bf16_t* yb; const float* bias; const float* lw; int orow0, n0, s0, cnt; float bsc;
    __device__ __forceinline__ void operator()(f32x4 (&acc)[8][4], const Wv& w0) const { const LaneXY w = opaque_xy(w0);
        const int colw = n0 + w.wn * 64;
        f32x4 bv[4];
#pragma unroll
        for (int j = 0; j < 4; ++j) bv[j] = *(const f32x4*)(bias + colw + PCOL(j, w.lq)) * bsc;
#pragma unroll
        for (int i = 0; i < 8; ++i) { const int r = w.wm * 128 + i * 16 + w.lr; const int sl = s0 + r; const float rw = (sl < cnt) ? lw[sl] : 0.f;
            if (sl < cnt) st_row_bf16(yb + (size_t)(orow0 + r) * D + colw, w.lq, (acc[i][0] + bv[0]) * rw, (acc[i][1] + bv[1]) * rw, (acc[i][2] + bv[2]) * rw, (acc[i][3] + bv[3]) * rw); }
    }
};

__device__ __forceinline__ void moe_tables(LAS unsigned char* lds, const unsigned* cntg) {
    LAS int* tab = (LAS int*)(lds + LDS_TAB);
    const int t = threadIdx.x;
    if (t < 64) {
        const int c = (t < 32) ? (int)cntg[16 * (t & 31)] : 0; const int nt = (c + 255) >> 8;
        int incl = nt;
#pragma unroll
        for (int o = 1; o < 32; o <<= 1) { const int v = __shfl_up(incl, o, 64); if (t >= o) incl += v; }
        if (t < 32) { tab[t] = c; tab[32 + t] = nt; tab[64 + t] = incl - nt; }
        if (t == 31) tab[96] = incl; }
    __syncthreads();
}
__device__ __forceinline__ void moe_decode(LAS unsigned char* lds, int u, int NN, int& e, int& ti, int& pn) {
    const LAS int* tab = (const LAS int*)(lds + LDS_TAB);
    const int ln = (int)(threadIdx.x & 63u);
    const bool past = (ln < 32) && (u >= tab[64 + ln + 1] * NN);
    int ee = __builtin_popcountll(__ballot(past)); if (ee > 31) ee = 31;
    const int rem = u - tab[64 + ee] * NN, nt = tab[32 + ee];
    const int pn_ = rem / nt;
    e = __builtin_amdgcn_readfirstlane(ee); pn = __builtin_amdgcn_readfirstlane(pn_); ti = __builtin_amdgcn_readfirstlane(rem - pn_ * nt);
}

__device__ __forceinline__ void ld_dense(LoadDesc& L, const Wv& w, const void* Ap, unsigned Abytes, int row0, int pitchB, int colB, const void* Wp, unsigned Wbytes, int ldw, int k0, int n0, int nkt, int wes = 4  ) {
    L.Ap = Ap; L.Abytes = Abytes; L.arow[0] = (unsigned)((row0 + dma_row(w, 0)) * pitchB + colB + dma_chunk(w, 0) * 16); L.arow[1] = 0u; L.arow[2] = 0u; L.arow[3] = 0u; L.apitch64 = 64 * pitchB;
    L.Wp = Wp; L.Wbytes = Wbytes; L.bvoff = (unsigned)(((w.wid * 8 + k0) * ldw + n0 + 4 * w.lane) * wes); L.ldwb = ldw * wes; L.nkt = nkt; L.nvalid = 256;
}
struct SchedProj {
    static constexpr bool ROWSKIP = false;
    typedef EpiProj Epi;
    const bf16_t* hbuf; const bf16_t* w_in; bf16_t* proj; bf16_t* vt; const float* b_in; int first, stride, count;
    __device__ __forceinline__ bool next(int i, const Wv& w, LoadDesc& L, Epi& E) const {
        if (i >= count) return false;
        const int u = first + i * stride; const int v = u % 104; const int pm = (u / 104) * 4 + (v & 3), pn = v >> 2; const int m0 = pm * 256, n0 = pn * 256;
        ld_dense(L, w, hbuf, (unsigned)((size_t)T * HS * 2), m0, HS * 2, 0, w_in, (unsigned)((size_t)D * INW * 2), INW, 0, n0, D / 64, 2);
        E = EpiProj{proj, vt, b_in, m0, n0}; return true; }
};
struct SchedWc {
    static constexpr bool ROWSKIP = false;
    typedef EpiWc Epi;
    const bf16_t* wms; const float* w_pool_branch; bf16_t* wc; int g, n0;
    __device__ __forceinline__ bool next(int i, const Wv& w, LoadDesc& L, Epi& E) const {
        if (i >= 1) return false;
        ld_dense(L, w, wms, 4u * 256u * 256u * 2u, g * 256, 512, 0, w_pool_branch + (size_t)g * 256 * D, 256u * 2048u * 4u, D, 0, n0, 4);
        E = EpiWc{wc, g * 256, n0}; return true; }
};
struct SchedBranch {
    static constexpr bool ROWSKIP = false;
    typedef EpiBranch Epi;
    const bf16_t* att; const bf16_t* pg; const bf16_t* w_a; const bf16_t* wc; bf16_t* mrgf; bf16_t* mrg; const bf16_t* proj; int first, stride, count;
    __device__ __forceinline__ bool next(int i, const Wv& w, LoadDesc& L, Epi& E) const {
        if (i >= 2 * count) return false;
        const int u = first + (i >> 1) * stride, second = i & 1; const int v = u & 31; const int pm = (u >> 5) * 4 + (v & 3), pn = v >> 2; const int m0 = pm * 256, n0 = pn * 256;
        ld_dense(L, w, second ? pg : att, (unsigned)((size_t)T * 1024 * 2), m0, 2048, 0, second ? wc : w_a, 1024u * 2048u * 2u, D, 0, n0, 16, 2);
        E = EpiBranch{mrgf, mrg, proj, m0, n0, second}; return true; }
};
struct SchedOut {
    static constexpr bool ROWSKIP = false;
    typedef EpiOut Epi;
    const bf16_t* mrg; const bf16_t* w_out; bf16_t* mix; int first, stride, count;
    __device__ __forceinline__ bool next(int i, const Wv& w, LoadDesc& L, Epi& E) const {
        if (i >= count) return false;
        const int u = first + i * stride; const int v = u & 31; const int pm = (u >> 5) * 4 + (v & 3), pn = v >> 2; const int m0 = pm * 256, n0 = pn * 256;
        ld_dense(L, w, mrg, (unsigned)((size_t)T * D * 2), m0, D * 2, 0, w_out, 2048u * 2048u * 2u, D, 0, n0, D / 64, 2);
        E = EpiOut{mix, m0, n0}; return true; }
};
struct SchedGateUp {
    static constexpr bool ROWSKIP = false;
    typedef EpiSwiglu Epi;
    LAS unsigned char* lds; const bf16_t* hbuf; const int* ltok; const float* w_gate_up; const float* b_gate_up; bf16_t* act; int first, stride, uend;
    __device__ __forceinline__ bool next(int i, const Wv& w, LoadDesc& L, Epi& E) const {
        const int u = first + i * stride; if (u >= uend) return false;
        const LAS int* tab = (const LAS int*)(lds + LDS_TAB);
        int e, ti, pn; moe_decode(lds, u, 16, e, ti, pn);
        const int cnt = __builtin_amdgcn_readfirstlane(tab[e]), s0 = ti * 256, orow0 = __builtin_amdgcn_readfirstlane(tab[64 + e]) * 256 + s0, n0 = pn * 256;
        L.Ap = hbuf; L.Abytes = (unsigned)((size_t)T * HS * 2); L.apitch64 = 0;
        { unsigned tk[4];
#pragma unroll
          for (int p = 0; p < 4; ++p) { const int sl = s0 + dma_row(w, p); tk[p] = (sl < cnt) ? (unsigned)ltok[e * T + sl] * (unsigned)(HS * 2) + (unsigned)((w.lane & 7) * 16) : 0xfffffff0u; }
          L.arow[0] = tk[0]; L.arow[1] = tk[1]; L.arow[2] = tk[2]; L.arow[3] = tk[3]; }
        L.Wp = w_gate_up + (size_t)e * 2048 * 4096; L.Wbytes = 2048u * 4096u * 4u; L.bvoff = (unsigned)(((w.wid * 8) * 4096 + n0 + 4 * w.lane) * 4); L.ldwb = 4096 * 4; L.nkt = D / 64; L.nvalid = (cnt - s0 < 256) ? cnt - s0 : 256;
        E = EpiSwiglu{act, b_gate_up + (size_t)e * 4096, orow0, n0, (cnt - s0 < 256) ? cnt - s0 : 256}; return true; }
};
struct SchedDown {
    static constexpr bool ROWSKIP = false;
    typedef EpiDown Epi;
    LAS unsigned char* lds; const bf16_t* act; const float* lw; const float* w_down; const float* b_down; bf16_t* yb; bf16_t* yb2; unsigned char* sflag; int first, stride, nfull, last, lastkh;
    __device__ __forceinline__ bool next(int i, const Wv& w, LoadDesc& L, Epi& E) const {
        if (i > nfull || (i == nfull && last < 0)) return false;
        const bool fin = (i == nfull); const int u = fin ? last : first + i * stride; const int kh = fin ? lastkh : -1;
        const LAS int* tab = (const LAS int*)(lds + LDS_TAB);
        int e, ti, pn; moe_decode(lds, u, 8, e, ti, pn);
        const int cnt = __builtin_amdgcn_readfirstlane(tab[e]), s0 = ti * 256, tile = __builtin_amdgcn_readfirstlane(tab[64 + e]) + ti, orow0 = tile * 256, n0 = pn * 256;
        const int k0 = (kh > 0) ? 1024 : 0;
        ld_dense(L, w, act, (unsigned)((size_t)NPADROWS * DFF * 2), orow0, DFF * 2, k0 * 2, w_down + (size_t)e * 2048 * 2048, 2048u * 2048u * 4u, 2048, k0, n0, (kh >= 0) ? 16 : 32);
        L.nvalid = (cnt - s0 < 256) ? cnt - s0 : 256;
#pragma unroll
        for (int p = 0; p < 4; ++p) { const int r = dma_row(w, p); L.arow[p] = (s0 + r < cnt) ? (unsigned)((orow0 + r) * (DFF * 2) + k0 * 2 + dma_chunk(w, p) * 16) : 0xfffffff0u; }
        L.apitch64 = 0;
        if (kh >= 0 && w.wid == 0 && w.lane == 0) sflag[tile * 8 + pn] = 1;
        E = EpiDown{(kh > 0) ? yb2 : yb, b_down + (size_t)e * 2048, lw + (size_t)e * T, orow0, n0, s0, cnt, (kh > 0) ? 0.f : 1.f}; return true; }
};

template <int WL>
__device__ __forceinline__ void pool_run(const bf16_t* proj, bf16_t* pg, int tok0, int ch) {
    const int tin0 = tok0 & (SEQ - 1);
    const bf16_t* base = proj + (size_t)tok0 * INW + 1536 + ch * 8;
    u32x4 r[WL + 7];
#pragma unroll
    for (int j = 0; j < WL + 7; ++j) { const int d = j - (WL - 1); r[j] = (u32x4){0u, 0u, 0u, 0u}; if (d >= 0 || tin0 + d >= 0) r[j] = *(const u32x4*)(base + (long)d * INW); }
    float s[8];
#pragma unroll
    for (int e = 0; e < 8; ++e) s[e] = 0.f;
#pragma unroll
    for (int j = 0; j < WL; ++j) { s[0] += bf_lo(r[j].x); s[1] += bf_hi(r[j].x); s[2] += bf_lo(r[j].y); s[3] += bf_hi(r[j].y); s[4] += bf_lo(r[j].z); s[5] += bf_hi(r[j].z); s[6] += bf_lo(r[j].w); s[7] += bf_hi(r[j].w); }
#pragma unroll
    for (int t = 0; t < 8; ++t) {
        if (t > 0) { const u32x4 a = r[WL - 1 + t], b = r[t - 1];
            s[0] += bf_lo(a.x) - bf_lo(b.x); s[1] += bf_hi(a.x) - bf_hi(b.x); s[2] += bf_lo(a.y) - bf_lo(b.y); s[3] += bf_hi(a.y) - bf_hi(b.y);
            s[4] += bf_lo(a.z) - bf_lo(b.z); s[5] += bf_hi(a.z) - bf_hi(b.z); s[6] += bf_lo(a.w) - bf_lo(b.w); s[7] += bf_hi(a.w) - bf_hi(b.w); }
        const int n = (tin0 + t + 1 < WL) ? tin0 + t + 1 : WL; const float rn = 1.0f / (float)n; const u32x4 u0 = r[WL - 1 + t];
        u32x4 ov; ov.x = pk_bf16(s[0] * rn - bf_lo(u0.x), s[1] * rn - bf_hi(u0.x)); ov.y = pk_bf16(s[2] * rn - bf_lo(u0.y), s[3] * rn - bf_hi(u0.y));
        ov.z = pk_bf16(s[4] * rn - bf_lo(u0.z), s[5] * rn - bf_hi(u0.z)); ov.w = pk_bf16(s[6] * rn - bf_lo(u0.w), s[7] * rn - bf_hi(u0.w));
        *(u32x4*)(pg + (size_t)(tok0 + t) * 1024 + ch * 8) = ov; }
}

__global__ void __launch_bounds__(512, 2) mk_fwd(Args args) {
    extern __shared__ __attribute__((aligned(16))) unsigned char lds_raw[];
    LAS unsigned char* lds = (LAS unsigned char*)lds_raw;
    const int tid = threadIdx.x, lane = tid & 63, wid = __builtin_amdgcn_readfirstlane(tid >> 6), blk = blockIdx.x;
#define PHASE_IDS() int tid_o_ = threadIdx.x; asm volatile("" : "+v"(tid_o_)); const int tid = tid_o_, lane = tid & 63, wid = __builtin_amdgcn_readfirstlane(tid >> 6); (void)tid; (void)lane; (void)wid
    unsigned char* ws = args.ws;
    const float* x = args.in[0]; const float* cvec = args.in[1]; const float* w_mod = args.in[2]; const float* b_mod = args.in[3];
    const float* g_pre_mix = args.in[4]; const float* g_post_mix = args.in[5]; const float* w_in = args.in[6]; const float* b_in = args.in[7];
    const float* sinks = args.in[8]; const float* w_pool_mix = args.in[9]; const float* pool_scale = args.in[10];
    const float* w_attn_branch = args.in[11]; const float* w_pool_branch = args.in[12]; const float* w_out = args.in[13];
    const float* g_pre_ffn = args.in[14]; const float* g_post_ffn = args.in[15]; const float* w_router = args.in[16]; const float* b_router = args.in[17];
    const float* w_gate_up = args.in[18]; const float* b_gate_up = args.in[19]; const float* w_down = args.in[20]; const float* b_down = args.in[21];
    float* out = args.out;
    unsigned* ctl = (unsigned*)(ws + WS_CTL);
    unsigned* cntg = (unsigned*)(ws + WS_CTL + CTL_CNT_OFF);
    float* modv = (float*)(ws + WS_MOD);
    bf16_t* wrt = (bf16_t*)(ws + WS_WRT);
    bf16_t* hbuf = (bf16_t*)(ws + WS_H);
    bf16_t* proj = (bf16_t*)(ws + WS_PROJ);
    bf16_t* x1b = (bf16_t*)(ws + WS_PROJ);
    bf16_t* vt = (bf16_t*)(ws + WS_VT);
    bf16_t* att = (bf16_t*)(ws + WS_ATT);
    bf16_t* pg = (bf16_t*)(ws + WS_PG);
    bf16_t* wc = (bf16_t*)(ws + WS_PP);
    bf16_t* wms = (bf16_t*)(ws + WS_WMS);
    bf16_t* mrgf = (bf16_t*)(ws + WS_MRGF);
    bf16_t* mrg = (bf16_t*)(ws + WS_MRG);
    bf16_t* mix = (bf16_t*)(ws + WS_MIX);
    int* ltok = (int*)(ws + WS_LTOK);
    float* lw = (float*)(ws + WS_LW);
    int* tslot = (int*)(ws + WS_TSLOT);
    bf16_t* act = (bf16_t*)(ws + WS_ACT);
    bf16_t* yb = (bf16_t*)(ws + WS_YB);
    bf16_t* yb2 = (bf16_t*)(ws + WS_YB2);
    bf16_t* wbin = (bf16_t*)(ws + WS_WBIN); bf16_t* wba = (bf16_t*)(ws + WS_WBA); bf16_t* wbo = (bf16_t*)(ws + WS_WBO);
    unsigned char* sflag = (unsigned char*)(ws + WS_CTL + CTL_FLAG_OFF);

    if (tid < 4) ((LAS unsigned*)(lds + LDS_BAR))[tid] = 0u;
    __syncthreads();
    XcdBarrier bar; bar.bar = ctl; bar.x = 0; bar.st = nullptr;
    if (MK_N_LAUNCHES == 1) bar = xcd_barrier_post(ctl, (volatile LAS unsigned*)(lds + LDS_BAR));
    if (MK_N_LAUNCHES == 1 && tid == 0) { const unsigned xx = xb_xcc_id(); ((LAS unsigned*)(lds + LDS_BAR))[2] = xx; ((LAS unsigned*)(lds + LDS_BAR))[3] = xb_add((unsigned*)(ws + WS_CTL + CTL_RANK_OFF) + 64 * xx, 1u); }
    __syncthreads();
    const int lo = args.ph_lo, hi = args.ph_hi;
#ifndef PH_MASK
#define PH_MASK 0x7ff
#endif
#ifndef REP_MASK
#define REP_MASK 0
#endif
#define REPS(k) ((((REP_MASK) >> (k)) & 1) ? 2 : 1)
#define IN(k) ((((PH_MASK) >> (k)) & 1) && lo <= (k) && (k) < hi)
#define SEAM(k) do { if (IN(k) && IN((k) + 1)) xcd_barrier(bar); } while (0)

    int xcd = blk & 7, rnk = blk >> 3, nxcd = 8, npx = (int)gridDim.x >> 3;
#define XCD_SETUP() do { if (MK_N_LAUNCHES == 1) { const LAS unsigned* st_ = (const LAS unsigned*)(lds + LDS_BAR); \
        xcd = __builtin_amdgcn_readfirstlane((int)st_[2]); rnk = __builtin_amdgcn_readfirstlane((int)st_[3]); npx = __builtin_amdgcn_readfirstlane((int)st_[0]); nxcd = __builtin_amdgcn_readfirstlane((int)st_[1]); \
        if (npx < 1) npx = 1; if (nxcd < 1) nxcd = 1; } } while (0)

    if (IN(0)) for (int rep_ = 0; rep_ < REPS(0); ++rep_) { PHASE_IDS();
        LAS float* sc = (LAS float*)(lds + LDS_MAIN);
        LAS float* part = (LAS float*)(lds + LDS_MAIN + 16384);
        for (int i = tid; i < 4096; i += 512) { const float cv = cvec[i]; sc[i] = cv / (1.0f + __expf(-cv)); }
        __syncthreads();
        { const int j0 = 16 * blk;
          if (tid < 504) {
            const int q = tid & 3, kl = tid >> 2;
            f32x4 a0 = {0.f, 0.f, 0.f, 0.f}, a1 = {0.f, 0.f, 0.f, 0.f};
            const float* wp = w_mod + j0 + 4 * q;
#pragma unroll 4
            for (int k = kl; k < 2048; k += 126) { const f32x4 wv4 = *(const f32x4*)(wp + (size_t)k * 12288); a0 += wv4 * sc[k]; a1 += wv4 * sc[2048 + k]; }
#pragma unroll
            for (int e = 0; e < 4; ++e) { part[kl * 32 + q * 4 + e] = a0[e]; part[kl * 32 + 16 + q * 4 + e] = a1[e]; }
          }
          __syncthreads();
          if (tid < 32) { float s = 0.f; for (int kl = 0; kl < 126; ++kl) s += part[kl * 32 + tid]; const int b = tid >> 4, jj = tid & 15; modv[b * 12288 + j0 + jj] = s + b_mod[j0 + jj]; } }
        { const int gt = blk * 512 + tid;
          for (int i = gt; i < D * INW / 8; i += 131072) { const f32x4 a = *(const f32x4*)(w_in + (size_t)i * 8), b = *(const f32x4*)(w_in + (size_t)i * 8 + 4); u32x4 o; o.x = pk_bf16(a[0], a[1]); o.y = pk_bf16(a[2], a[3]); o.z = pk_bf16(b[0], b[1]); o.w = pk_bf16(b[2], b[3]); *(u32x4*)(wbin + (size_t)i * 8) = o; }
          for (int i = gt; i < 1024 * D / 8; i += 131072) { const f32x4 a = *(const f32x4*)(w_attn_branch + (size_t)i * 8), b = *(const f32x4*)(w_attn_branch + (size_t)i * 8 + 4); u32x4 o; o.x = pk_bf16(a[0], a[1]); o.y = pk_bf16(a[2], a[3]); o.z = pk_bf16(b[0], b[1]); o.w = pk_bf16(b[2], b[3]); *(u32x4*)(wba + (size_t)i * 8) = o; }
          for (int i = gt; i < D * D / 8; i += 131072) { const f32x4 a = *(const f32x4*)(w_out + (size_t)i * 8), b = *(const f32x4*)(w_out + (size_t)i * 8 + 4); u32x4 o; o.x = pk_bf16(a[0], a[1]); o.y = pk_bf16(a[2], a[3]); o.z = pk_bf16(b[0], b[1]); o.w = pk_bf16(b[2], b[3]); *(u32x4*)(wbo + (size_t)i * 8) = o; } }
        for (int i = blk * 512 + tid; i < 4 * 65536; i += 131072) { const int g = i >> 16, d = i & 255; wms[i] = (bf16_t)(pk_bf16(w_pool_mix[i] * pool_scale[g * 256 + d], 0.f) & 0xffffu); }
        { const int i = blk * 512 + tid; if (i < 65536) { const int e = i & 31, k = i >> 5; wrt[e * 2048 + k] = (bf16_t)(pk_bf16(w_router[i], 0.f) & 0xffffu); } }
        __syncthreads();
    }
    SEAM(0);
    if (MK_N_LAUNCHES == 1 && IN(0) && IN(1)) {
        if (threadIdx.x == 0) { LAS unsigned* st_ = (LAS unsigned*)(lds + LDS_BAR); const unsigned hx_ = st_[2]; unsigned ord_ = 0;
            for (unsigned j = 0; j < 16; ++j) { const unsigned c_ = ctl[XB_XCNT(j)]; if (j < hx_ && c_ > 0u) ++ord_; }
            st_[2] = ord_; }
        __syncthreads();
    }

    if (IN(1)) for (int rep_ = 0; rep_ < REPS(1); ++rep_) { PHASE_IDS();
        { const int rowb = blk * 32 + wid * 4; const int b = rowb >> 12;
          f32x4 cgs[8], csh[8];
#pragma unroll
          for (int j = 0; j < 8; ++j) { const int col = 4 * lane + 256 * j; cgs[j] = *(const f32x4*)(g_pre_mix + col) * (*(const f32x4*)(modv + b * 12288 + 2048 + col) + 1.0f); csh[j] = *(const f32x4*)(modv + b * 12288 + col); }
          f32x4 xw[2][8];
#pragma unroll
          for (int j = 0; j < 8; ++j) xw[0][j] = *(const f32x4*)(x + (size_t)rowb * D + 4 * lane + 256 * j);
#pragma unroll
          for (int rr = 0; rr < 4; ++rr) { const int sb = rr & 1; const int row = rowb + rr;
            if (rr < 3) {
#pragma unroll
                for (int j = 0; j < 8; ++j) xw[sb ^ 1][j] = *(const f32x4*)(x + (size_t)(row + 1) * D + 4 * lane + 256 * j); }
            float ss = 0.f;
#pragma unroll
            for (int j = 0; j < 8; ++j) { const f32x4 xv = xw[sb][j]; ss += xv[0] * xv[0] + xv[1] * xv[1] + xv[2] * xv[2] + xv[3] * xv[3]; }
            ss = wave_sum(ss); const float r = rsqrtf(ss * (1.0f / D) + RMS_EPS);
#pragma unroll
            for (int j = 0; j < 8; ++j) { const int col = 4 * lane + 256 * j;
                const f32x4 h = xw[sb][j] * r * cgs[j] + csh[j];
                u32x2 o; o.x = pk_bf16(h[0], h[1]); o.y = pk_bf16(h[2], h[3]); *(u32x2*)(hbuf + (size_t)row * HS + col) = o; }
          } }
    }
    SEAM(1);

    if (IN(2)) for (int rep_ = 0; rep_ < REPS(2); ++rep_) { PHASE_IDS();
        XCD_SETUP();
        const int U = 32 * 26; const int ulo = (U * xcd) / nxcd, uhi = (U * (xcd + 1)) / nxcd;
        { int cnt3 = 0; for (int k = 0; k < 3; ++k) if (ulo + rnk + k * npx < uhi) ++cnt3;
          SchedProj S{hbuf, wbin, proj, vt, b_in, ulo + rnk, npx, cnt3}; gemm_stream<SchedProj, false, true>(lds, S); }
    }
    SEAM(2);

    if (IN(3)) for (int rep_ = 0; rep_ < REPS(3); ++rep_) { PHASE_IDS();
        XCD_SETUP();
        int nleft, wk, nwk;
        { const int U = 32 * 26; const int ulo = (U * xcd) / nxcd, uhi = (U * (xcd + 1)) / nxcd; nleft = uhi - ulo - 3 * npx; if (nleft < 0) nleft = 0; if (nleft > npx - 1) nleft = npx - 1;
          if (rnk < nleft) { int c = 0; for (int u = ulo + 3 * npx + rnk; u < uhi; u += nleft) ++c; SchedProj S{hbuf, wbin, proj, vt, b_in, ulo + 3 * npx + rnk, nleft, c}; gemm_stream<SchedProj, false, true>(lds, S); }
          wk = rnk - nleft; nwk = npx - nleft; }
        const int alo = (256 * xcd) / nxcd, ahi = (256 * (xcd + 1)) / nxcd;
        if (wk >= 0) for (int u = alo + wk; u < ahi; u += nwk) {
            const int b = u >> 7, nb = (u >> 2) & 31, kvh = u & 3;
            const int tok0 = b * SEQ + nb * 128;
            LAS unsigned char* Kl = lds + LDS_MAIN;
            LAS unsigned char* Vl = lds + LDS_MAIN + 32768;
            __syncthreads();
#pragma unroll
            for (int p = 0; p < 4; ++p) { const int q = tid + 512 * p; const int row = q >> 3, ch = q & 7; const bool ok = (nb > 0) || (row >= 128);
                u32x4 v = {0u, 0u, 0u, 0u};
                if (ok) v = *(const u32x4*)(proj + (size_t)(tok0 - 128 + row) * INW + 1024 + kvh * 64 + ch * 8);
                *(LAS u32x4*)(Kl + row * 128 + ((ch ^ swz(row)) << 4)) = v; }
#pragma unroll
            for (int p = 0; p < 4; ++p) { const int q = tid + 512 * p; const int d = q >> 5, ch = q & 31; const bool ok = (nb > 0) || (ch >= 16);
                u32x4 v = {0u, 0u, 0u, 0u};
                if (ok) v = *(const u32x4*)(vt + ((size_t)((b * 4 + kvh) * 64 + d)) * SEQ + (nb * 128 - 128 + ch * 8));
                *(LAS u32x4*)(Vl + d * 528 + ch * 16) = v; }
            __syncthreads();
            const int g = wid >> 1, half = wid & 1, hq = kvh * 4 + g;
            const float sink2 = sinks[hq] * LOG2E;
            const int lr = lane & 15, lq = lane >> 4;
#pragma unroll 1
            for (int a4 = 0; a4 < 4; ++a4) {
                const int a = half * 4 + a4; const int qrow = tok0 + 16 * a + lr; const int p0 = a >> 1;
                bf16x8 qf[2];
#pragma unroll
                for (int ks = 0; ks < 2; ++ks) qf[ks] = *(const bf16x8*)(proj + (size_t)qrow * INW + hq * 64 + ks * 32 + lq * 8);
                f32x4 s[10];
#pragma unroll
                for (int ff = 0; ff < 10; ++ff) { const int krow = 16 * (2 * p0 + ff) + lr; const int sw = swz(krow);
                    const bf16x8 k0 = *(const LAS bf16x8*)(Kl + krow * 128 + (((0 + lq) ^ sw) << 4));
                    const bf16x8 k1 = *(const LAS bf16x8*)(Kl + krow * 128 + (((4 + lq) ^ sw) << 4));
                    f32x4 z = {0.f, 0.f, 0.f, 0.f};
                    z = __builtin_amdgcn_mfma_f32_16x16x32_bf16(k0, qf[0], z, 0, 0, 0);
                    s[ff] = __builtin_amdgcn_mfma_f32_16x16x32_bf16(k1, qf[1], z, 0, 0, 0); }
                const int iq = 16 * a + lr; float m = sink2;
#pragma unroll
                for (int ff = 0; ff < 10; ++ff)
#pragma unroll
                    for (int e = 0; e < 4; ++e) { const int kp = 16 * (2 * p0 + ff) + 4 * lq + e; const bool ok = (kp > iq) && (kp <= iq + 128) && ((nb > 0) || (kp >= 128));
                        s[ff][e] = ok ? s[ff][e] : -1e30f; m = fmaxf(m, s[ff][e]); }
                m = fmaxf(m, __shfl_xor(m, 16)); m = fmaxf(m, __shfl_xor(m, 32));
                float sum = 0.f;
#pragma unroll
                for (int ff = 0; ff < 10; ++ff)
#pragma unroll
                    for (int e = 0; e < 4; ++e) { const float pv = exp2f(s[ff][e] - m); s[ff][e] = pv; sum += pv; }
                sum += __shfl_xor(sum, 16); sum += __shfl_xor(sum, 32);
                sum += exp2f(sink2 - m);
                const float inv = 1.0f / sum;
                f32x4 o[4];
#pragma unroll
                for (int df = 0; df < 4; ++df) o[df] = (f32x4){0.f, 0.f, 0.f, 0.f};
#pragma unroll
                for (int pr = 0; pr < 5; ++pr) {
                    u32x4 pw; pw.x = pk_bf16(s[2 * pr][0], s[2 * pr][1]); pw.y = pk_bf16(s[2 * pr][2], s[2 * pr][3]); pw.z = pk_bf16(s[2 * pr + 1][0], s[2 * pr + 1][1]); pw.w = pk_bf16(s[2 * pr + 1][2], s[2 * pr + 1][3]);
                    const bf16x8 pf = __builtin_bit_cast(bf16x8, pw);
                    const int key0 = 16 * (2 * p0 + 2 * pr) + 4 * lq;
#pragma unroll
                    for (int df = 0; df < 4; ++df) { const LAS unsigned char* vp = Vl + (16 * df + lr) * 528 + key0 * 2;
                        const u32x2 v0 = *(const LAS u32x2*)vp, v1 = *(const LAS u32x2*)(vp + 32);
                        u32x4 vw; vw.x = v0.x; vw.y = v0.y; vw.z = v1.x; vw.w = v1.y;
                        o[df] = __builtin_amdgcn_mfma_f32_16x16x32_bf16(__builtin_bit_cast(bf16x8, vw), pf, o[df], 0, 0, 0); }
                }
#pragma unroll
                for (int df = 0; df < 4; ++df) { u32x2 ov; ov.x = pk_bf16(o[df][0] * inv, o[df][1] * inv); ov.y = pk_bf16(o[df][2] * inv, o[df][3] * inv);
                    *(u32x2*)(att + (size_t)qrow * 1024 + hq * 64 + 16 * df + 4 * lq) = ov; }
            }
        }
        if (wk >= 0) {
            const int tlo = (T * xcd) / nxcd, thi = (T * (xcd + 1)) / nxcd;
            if (((thi - tlo) & 15) == 0) {
                const int nit = (thi - tlo) / 4;
#pragma unroll 1
                for (int it = wk * 8 + wid; it < nit; it += nwk * 8) { const int gi = it & 3, tok0 = tlo + ((it >> 2) * 2 + (lane >> 5)) * 8, ch = gi * 32 + (lane & 31);
                    if (gi == 0) pool_run<2>(proj, pg, tok0, ch); else if (gi == 1) pool_run<4>(proj, pg, tok0, ch); else if (gi == 2) pool_run<8>(proj, pg, tok0, ch); else pool_run<16>(proj, pg, tok0, ch); }
            } else {
            const int nitem = (thi - tlo) * 2;
#pragma unroll 1
            for (int it = wk * 8 + wid; it < nitem; it += nwk * 8) {
                const int gi = it & 3, tok = tlo + (it >> 2) * 2 + (lane >> 5), ch = gi * 32 + (lane & 31); const int tin = tok & (SEQ - 1);
                const int wl = 2 << gi; const int n = (tin + 1 < wl) ? tin + 1 : wl;
                float sacc[8];
#pragma unroll
                for (int e = 0; e < 8; ++e) sacc[e] = 0.f;
                const bf16_t* up = proj + (size_t)tok * INW + 1536 + ch * 8;
                const u32x4 u0 = *(const u32x4*)up;
                { u32x4 uv[16];
#pragma unroll
                    for (int k = 0; k < 16; ++k) { uv[k] = (u32x4){0u, 0u, 0u, 0u}; if (k < n) uv[k] = *(const u32x4*)(up - (size_t)k * INW); }
#pragma unroll
                    for (int k = 0; k < 16; ++k) { sacc[0] += bf_lo(uv[k].x); sacc[1] += bf_hi(uv[k].x); sacc[2] += bf_lo(uv[k].y); sacc[3] += bf_hi(uv[k].y); sacc[4] += bf_lo(uv[k].z); sacc[5] += bf_hi(uv[k].z); sacc[6] += bf_lo(uv[k].w); sacc[7] += bf_hi(uv[k].w); } }
                const float rn = 1.0f / (float)n;
                u32x4 ov; ov.x = pk_bf16(sacc[0] * rn - bf_lo(u0.x), sacc[1] * rn - bf_hi(u0.x)); ov.y = pk_bf16(sacc[2] * rn - bf_lo(u0.y), sacc[3] * rn - bf_hi(u0.y));
                ov.z = pk_bf16(sacc[4] * rn - bf_lo(u0.z), sacc[5] * rn - bf_hi(u0.z)); ov.w = pk_bf16(sacc[6] * rn - bf_lo(u0.w), sacc[7] * rn - bf_hi(u0.w));
                *(u32x4*)(pg + (size_t)tok * 1024 + ch * 8) = ov;
            } }
        }
        if (wk >= 0) {
            LAS int* tk = (LAS int*)(lds + LDS_TAB);
            for (;;) {
                __syncthreads();
                if (tid == 0) tk[0] = (int)atomicAdd(ctl + CTL_TICKET_OFF / 4 + 64, 1u);
                __syncthreads();
                const int tkt = __builtin_amdgcn_readfirstlane(tk[0]);
                if (tkt >= 32) break;
                { SchedWc S{wms, w_pool_branch, wc, tkt >> 3, (tkt & 7) * 256}; gemm_stream(lds, S); }
            }
        }
        if (wk >= 0) {
            LAS float* sc = (LAS float*)(lds + LDS_MAIN);
            LAS float* part = (LAS float*)(lds + LDS_MAIN + 16384);
            LAS int* tk = (LAS int*)(lds + LDS_TAB);
            __syncthreads();
            for (int i = tid; i < 4096; i += 512) { const float cv = cvec[i]; sc[i] = cv / (1.0f + __expf(-cv)); }
            for (;;) {
                __syncthreads();
                if (tid == 0) tk[0] = (int)atomicAdd(ctl + CTL_TICKET_OFF / 4, 1u);
                __syncthreads();
                const int cb = __builtin_amdgcn_readfirstlane(tk[0]);
                if (cb >= 171) break;
                const int j0 = 4096 + 48 * cb; const int ncol = (j0 + 48 <= 12288) ? 48 : 12288 - j0;
                if (tid < 504) {
                    const int q = tid % 12, kl = tid / 12;
                    f32x4 a0 = {0.f, 0.f, 0.f, 0.f}, a1 = {0.f, 0.f, 0.f, 0.f};
                    if (4 * q < ncol) { const float* wp = w_mod + j0 + 4 * q;
#pragma unroll 7
                        for (int k = kl; k < 2048; k += 42) { const f32x4 wv4 = *(const f32x4*)(wp + (size_t)k * 12288); a0 += wv4 * sc[k]; a1 += wv4 * sc[2048 + k]; } }
#pragma unroll
                    for (int e = 0; e < 4; ++e) { part[kl * 96 + q * 4 + e] = a0[e]; part[kl * 96 + 48 + q * 4 + e] = a1[e]; }
                }
                __syncthreads();
                if (tid < 96) { float s2 = 0.f; for (int kl = 0; kl < 42; ++kl) s2 += part[kl * 96 + tid]; const int b = tid / 48, jj = tid % 48; if (jj < ncol) modv[b * 12288 + j0 + jj] = s2 + b_mod[j0 + jj]; }
            }
        }
        __syncthreads();
    }
    SEAM(3);


    if (IN(5)) for (int rep_ = 0; rep_ < REPS(5); ++rep_) { PHASE_IDS();
        XCD_SETUP();
        const int ulo = (256 * xcd) / nxcd, uhi = (256 * (xcd + 1)) / nxcd;
        { int c = 0; for (int u = ulo + rnk; u < uhi; u += npx) ++c;
          SchedBranch S{att, pg, wba, wc, mrgf, mrg, proj, ulo + rnk, npx, c}; gemm_stream<SchedBranch, false, true>(lds, S); }
    }
    SEAM(5);

    if (IN(6)) for (int rep_ = 0; rep_ < REPS(6); ++rep_) { PHASE_IDS();
        XCD_SETUP();
        const int ulo = (256 * xcd) / nxcd, uhi = (256 * (xcd + 1)) / nxcd;
        { int c = 0; for (int u = ulo + rnk; u < uhi; u += npx) ++c;
          SchedOut S{mrg, wbo, mix, ulo + rnk, npx, c}; gemm_stream<SchedOut, false, true>(lds, S); }
    }
    SEAM(6);

    if (IN(7)) { PHASE_IDS();
        LAS unsigned char* h2s = lds + LDS_MAIN;
        LAS float* part = (LAS float*)(lds + LDS_MAIN);
        LAS float* lgt = (LAS float*)(lds + LDS_MAIN + 32768);
        LAS int* lcnt = (LAS int*)(lds + LDS_TAB);
        LAS int* sel = (LAS int*)(lds + LDS_TAB + 256);
        LAS float* selw = (LAS float*)(lds + LDS_TAB + 256 + 1024);
        for (int tile = blk; tile < T / 32; tile += gridDim.x) {
            __syncthreads();
            if (tid < 64) lcnt[tid] = 0;
            f32x4 cga[8], cgs[8], csh[8];
            const float* mb = modv + ((tile * 32) >> 12) * 12288;
            const __amdgpu_buffer_rsrc_t r_gpm = mk_rsrc(g_post_mix, 8192u), r_gpf = mk_rsrc(g_pre_ffn, 8192u), r_mod = mk_rsrc(mb, 12288u * 4u);
            const unsigned lo16 = (unsigned)(lane * 16);
#pragma unroll
            for (int j = 0; j < 8; ++j) {
                cga[j] = __builtin_bit_cast(f32x4, __builtin_amdgcn_raw_buffer_load_b128(r_gpm, lo16, 1024 * j, 0)) * __builtin_bit_cast(f32x4, __builtin_amdgcn_raw_buffer_load_b128(r_mod, lo16, 2 * 8192 + 1024 * j, 0));
                cgs[j] = __builtin_bit_cast(f32x4, __builtin_amdgcn_raw_buffer_load_b128(r_gpf, lo16, 1024 * j, 0)) * (__builtin_bit_cast(f32x4, __builtin_amdgcn_raw_buffer_load_b128(r_mod, lo16, 4 * 8192 + 1024 * j, 0)) + 1.0f);
                csh[j] = __builtin_bit_cast(f32x4, __builtin_amdgcn_raw_buffer_load_b128(r_mod, lo16, 3 * 8192 + 1024 * j, 0)); }
#pragma unroll 1
            for (int rr = 0; rr < 4; ++rr) {
                const int rl = wid * 4 + rr; const int row = tile * 32 + rl;
                f32x4 mv[8], xw[8]; float ss = 0.f;
                u32x2 mw[8];
#pragma unroll
                for (int j = 0; j < 8; ++j) { mw[j] = *(const u32x2*)(mix + (size_t)row * D + 4 * lane + 256 * j); xw[j] = *(const f32x4*)(x + (size_t)row * D + 4 * lane + 256 * j); }
#pragma unroll
                for (int j = 0; j < 8; ++j) { mv[j] = (f32x4){bf_lo(mw[j].x), bf_hi(mw[j].x), bf_lo(mw[j].y), bf_hi(mw[j].y)}; ss += mv[j][0] * mv[j][0] + mv[j][1] * mv[j][1] + mv[j][2] * mv[j][2] + mv[j][3] * mv[j][3]; }
                ss = wave_sum(ss); const float r1 = rsqrtf(ss * (1.0f / D) + RMS_EPS);
                float ss2 = 0.f;
#pragma unroll
                for (int j = 0; j < 8; ++j) { const int col = 4 * lane + 256 * j;
                    const f32x4 x1 = xw[j] + cga[j] * (mv[j] * r1);
                    { u32x2 xo; xo.x = pk_bf16(x1[0], x1[1]); xo.y = pk_bf16(x1[2], x1[3]); *(u32x2*)(x1b + (size_t)row * D + col) = xo; } mv[j] = x1;
                    ss2 += x1[0] * x1[0] + x1[1] * x1[1] + x1[2] * x1[2] + x1[3] * x1[3]; }
                ss2 = wave_sum(ss2); const float r2 = rsqrtf(ss2 * (1.0f / D) + RMS_EPS);
#pragma unroll
                for (int j = 0; j < 8; ++j) { const int col = 4 * lane + 256 * j;
                    const f32x4 h = mv[j] * r2 * cgs[j] + csh[j];
                    u32x2 o; o.x = pk_bf16(h[0], h[1]); o.y = pk_bf16(h[2], h[3]);
                    *(u32x2*)(hbuf + (size_t)row * HS + col) = o; *(LAS u32x2*)(h2s + rl * 4112 + col * 2) = o; }
            }
            __syncthreads();
            f32x4 lacc[2][2];
#pragma unroll
            for (int mi = 0; mi < 2; ++mi)
#pragma unroll
                for (int ni = 0; ni < 2; ++ni) lacc[mi][ni] = (f32x4){0.f, 0.f, 0.f, 0.f};
#pragma unroll
            for (int ks = 0; ks < 8; ++ks) { const int k0 = 256 * wid + 32 * ks + 8 * (lane >> 4);
                bf16x8 af[2], bfv[2];
#pragma unroll
                for (int mi = 0; mi < 2; ++mi) af[mi] = *(const LAS bf16x8*)(h2s + (16 * mi + (lane & 15)) * 4112 + k0 * 2);
#pragma unroll
                for (int ni = 0; ni < 2; ++ni) bfv[ni] = *(const bf16x8*)(wrt + (16 * ni + (lane & 15)) * 2048 + k0);
#pragma unroll
                for (int mi = 0; mi < 2; ++mi)
#pragma unroll
                    for (int ni = 0; ni < 2; ++ni) lacc[mi][ni] = __builtin_amdgcn_mfma_f32_16x16x32_bf16(af[mi], bfv[ni], lacc[mi][ni], 0, 0, 0); }
            __syncthreads();
#pragma unroll
            for (int mi = 0; mi < 2; ++mi)
#pragma unroll
                for (int ni = 0; ni < 2; ++ni)
#pragma unroll
                    for (int e = 0; e < 4; ++e) part[(wid * 32 + 16 * mi + 4 * (lane >> 4) + e) * 32 + 16 * ni + (lane & 15)] = lacc[mi][ni][e];
            __syncthreads();
            for (int o = tid; o < 1024; o += 512) { const int r = o >> 5, e = o & 31; float s = b_router[e];
#pragma unroll
                for (int ww = 0; ww < 8; ++ww) s += part[(ww * 32 + r) * 32 + e];
                lgt[r * 33 + e] = s; }
            __syncthreads();
            if (tid < 32) {
                const int r = tid; float vals[4]; int idx[4]; unsigned used = 0u;
#pragma unroll
                for (int k = 0; k < 4; ++k) { float best = -3.0e38f; int bi = 0;
                    for (int e = 0; e < 32; ++e) { const float v = lgt[r * 33 + e]; if (!((used >> e) & 1u) && v > best) { best = v; bi = e; } }
                    used |= 1u << bi; vals[k] = best; idx[k] = bi; }
                float ex[4], se = 0.f;
#pragma unroll
                for (int k = 0; k < 4; ++k) { ex[k] = __expf(vals[k] - vals[0]); se += ex[k]; }
#pragma unroll
                for (int k = 0; k < 4; ++k) { sel[r * 4 + k] = idx[k]; sel[128 + r * 4 + k] = atomicAdd((int*)&lcnt[idx[k]], 1); selw[r * 4 + k] = ex[k] / se; }
            }
            __syncthreads();
            if (tid < 32) { const int c = lcnt[tid]; lcnt[32 + tid] = c ? (int)atomicAdd(&cntg[16 * tid], (unsigned)c) : 0; }
            __syncthreads();
            if (tid < 128) { const int r = tid >> 2; const int e = sel[tid]; const int pos = lcnt[32 + e] + sel[128 + tid]; const int tok = tile * 32 + r;
                ltok[e * T + pos] = tok; lw[e * T + pos] = selw[tid]; tslot[tok * 4 + (tid & 3)] = (e << 16) | pos; }
        }
        __syncthreads();
    }
    SEAM(7);

    if (IN(8)) for (int rep_ = 0; rep_ < REPS(8); ++rep_) { PHASE_IDS();
        moe_tables(lds, cntg);
        const LAS int* tab = (const LAS int*)(lds + LDS_TAB);
        XCD_SETUP();
        const int U = __builtin_amdgcn_readfirstlane(tab[96]) * 16; const int ulo = (U * xcd) / nxcd, uhi = (U * (xcd + 1)) / nxcd;
        { SchedGateUp S{lds, hbuf, ltok, w_gate_up, b_gate_up, act, ulo + rnk, npx, uhi}; gemm_stream<SchedGateUp, true>(lds, S); }
    }
    SEAM(8);

    if (IN(9)) for (int rep_ = 0; rep_ < REPS(9); ++rep_) { PHASE_IDS();
        moe_tables(lds, cntg);
        const LAS int* tab = (const LAS int*)(lds + LDS_TAB);
        XCD_SETUP();
        const int U = __builtin_amdgcn_readfirstlane(tab[96]) * 8; const int ulo = (U * xcd) / nxcd, uhi = (U * (xcd + 1)) / nxcd;
        const int chunk = uhi - ulo, full = chunk / npx, rem = chunk - full * npx; const bool split = (rem > 0) && (2 * rem <= npx);
        { int last = -1, lastkh = -1;
          if (rem > 0) { if (split) { if (rnk < 2 * rem) { last = ulo + full * npx + (rnk >> 1); lastkh = rnk & 1; } } else if (rnk < rem) last = ulo + full * npx + rnk; }
          SchedDown S{lds, act, lw, w_down, b_down, yb, yb2, sflag, ulo + rnk, npx, full, last, lastkh}; gemm_stream<SchedDown, true>(lds, S); }
    }
    SEAM(9);

    if (IN(10)) { PHASE_IDS();
        moe_tables(lds, cntg);
        const LAS int* tab = (const LAS int*)(lds + LDS_TAB);
        const int row0 = blk * 32 + wid * 4; const int b = row0 >> 12;
        f32x4 gg[8];
#pragma unroll
        for (int q = 0; q < 8; ++q) { const int col = 8 * lane + 512 * (q >> 1) + 4 * (q & 1); gg[q] = *(const f32x4*)(g_post_ffn + col) * *(const f32x4*)(modv + b * 12288 + 5 * 2048 + col); }
        int prow[4][4]; unsigned long long fl[4][4];
#pragma unroll
        for (int rr = 0; rr < 4; ++rr) { const i32x4 ts = *(const i32x4*)(tslot + (size_t)(row0 + rr) * 4);
#pragma unroll
            for (int k = 0; k < 4; ++k) prow[rr][k] = tab[64 + (ts[k] >> 16)] * 256 + (ts[k] & 0xffff); }
#pragma unroll
        for (int rr = 0; rr < 4; ++rr)
#pragma unroll
            for (int k = 0; k < 4; ++k) fl[rr][k] = *(const unsigned long long*)(sflag + (size_t)(prow[rr][k] >> 8) * 8);
        const __amdgpu_buffer_rsrc_t y2rs = mk_rsrc(yb2, (unsigned)((size_t)NPADROWS * D * 2));
#pragma unroll
        for (int rr = 0; rr < 4; ++rr) { const int row = row0 + rr;
            u32x4 x1w[4];
#pragma unroll
            for (int j = 0; j < 4; ++j) x1w[j] = *(const u32x4*)(x1b + (size_t)row * D + 8 * lane + 512 * j);
            float yv[4][8]; float ss = 0.f;
#pragma unroll
            for (int j = 0; j < 4; ++j) { const int col = 8 * lane + 512 * j; const int pnb = 8 * (2 * j + (lane >> 5));
                u32x4 v[4], v2[4];
#pragma unroll
                for (int k = 0; k < 4; ++k) { v[k] = *(const u32x4*)(yb + (size_t)prow[rr][k] * D + col);
                    const unsigned off2 = ((fl[rr][k] >> pnb) & 1ull) ? (unsigned)((prow[rr][k] * D + col) * 2) : 0xfffffff0u;
                    v2[k] = __builtin_bit_cast(u32x4, __builtin_amdgcn_raw_buffer_load_b128(y2rs, off2, 0, 0)); }
#pragma unroll
                for (int e = 0; e < 8; ++e) yv[j][e] = 0.f;
#pragma unroll
                for (int k = 0; k < 4; ++k) { yv[j][0] += bf_lo(v2[k].x); yv[j][1] += bf_hi(v2[k].x); yv[j][2] += bf_lo(v2[k].y); yv[j][3] += bf_hi(v2[k].y); yv[j][4] += bf_lo(v2[k].z); yv[j][5] += bf_hi(v2[k].z); yv[j][6] += bf_lo(v2[k].w); yv[j][7] += bf_hi(v2[k].w); }
#pragma unroll
                for (int k = 0; k < 4; ++k) { yv[j][0] += bf_lo(v[k].x); yv[j][1] += bf_hi(v[k].x); yv[j][2] += bf_lo(v[k].y); yv[j][3] += bf_hi(v[k].y); yv[j][4] += bf_lo(v[k].z); yv[j][5] += bf_hi(v[k].z); yv[j][6] += bf_lo(v[k].w); yv[j][7] += bf_hi(v[k].w); }
#pragma unroll
                for (int e = 0; e < 8; ++e) ss += yv[j][e] * yv[j][e]; }
            ss = wave_sum(ss); const float r = rsqrtf(ss * (1.0f / D) + RMS_EPS);
#pragma unroll
            for (int q = 0; q < 8; ++q) { const int col = 8 * lane + 512 * (q >> 1) + 4 * (q & 1);
                const f32x4 y = {yv[q >> 1][4 * (q & 1)], yv[q >> 1][4 * (q & 1) + 1], yv[q >> 1][4 * (q & 1) + 2], yv[q >> 1][4 * (q & 1) + 3]};
                const u32x4 xw_ = x1w[q >> 1]; const f32x4 x1 = (q & 1) ? (f32x4){bf_lo(xw_.z), bf_hi(xw_.z), bf_lo(xw_.w), bf_hi(xw_.w)} : (f32x4){bf_lo(xw_.x), bf_hi(xw_.x), bf_lo(xw_.y), bf_hi(xw_.y)};
                *(f32x4*)(out + (size_t)row * D + col) = x1 + gg[q] * (y * r); }
        }
    }

#undef IN
#undef SEAM
}

extern "C" void kernel_launch(void* const* d_in, const int* in_sizes, int n_in, void* d_out, int out_size, void* d_ws, size_t ws_size, hipStream_t stream) {
    static int grid = 0;
    if (grid == 0) {
        if (n_in != 22 || out_size != T * D || ws_size < WS_END) { fprintf(stderr, "kernel_launch: unexpected shapes (n_in %d out %d ws %zu need %zu)\n", n_in, out_size, ws_size, (size_t)WS_END); grid = -1; return; }
        int dev = 0, cus = 0, per_cu = 0;
        if (hipGetDevice(&dev) != hipSuccess || hipDeviceGetAttribute(&cus, hipDeviceAttributeMultiprocessorCount, dev) != hipSuccess) { grid = -1; return; }
        if (hipFuncSetAttribute((const void*)mk_fwd, hipFuncAttributeMaxDynamicSharedMemorySize, LDS_BYTES) != hipSuccess) { fprintf(stderr, "kernel_launch: hipFuncSetAttribute failed\n"); grid = -1; return; }
        if (hipOccupancyMaxActiveBlocksPerMultiprocessor(&per_cu, (const void*)mk_fwd, 512, LDS_BYTES) != hipSuccess || per_cu < 1) fprintf(stderr, "kernel_launch: occupancy query says %d\n", per_cu);
        (void)hipGetLastError();
        grid = cus;
    }
    if (grid < 0) return;
    (void)hipMemsetAsync((char*)d_ws + WS_CTL, 0, CTL_BYTES, stream);
    Args a{};
    for (int i = 0; i < 22; ++i) a.in[i] = (const float*)d_in[i];
    a.out = (float*)d_out; a.ws = (unsigned char*)d_ws;
    if (MK_N_LAUNCHES == 1) {
        a.ph_lo = 0; a.ph_hi = NPHASE;
        hipLaunchKernelGGL(mk_fwd, dim3(grid), dim3(512), LDS_BYTES, stream, a);
    } else {
        for (int p = 0; p < NPHASE; ++p) { a.ph_lo = p; a.ph_hi = p + 1; hipLaunchKernelGGL(mk_fwd, dim3(grid), dim3(512), LDS_BYTES, stream, a); }
    }
    const hipError_t le = hipPeekAtLastError();
    if (le != hipSuccess) fprintf(stderr, "kernel_launch: launch failed: %s\n", hipGetErrorName(le));
}
```
